# Optimizing an MI355X kernel written in HIP

```python
import jax, jax.numpy as jnp
from jax import lax
import numpy as np

D_MODEL = 1024
BATCH = 8
SEQ = 2048
DEPTH = 1
DEC_BATCH = 128
DEC_SEQ = 4
PAST_LEN = 16384
PAGE_SIZE = 128

GM_WIDTH = D_MODEL
GM_GROUPS = 4
GM_CHUNK = 128
ML_HEADS = 4
ML_HEAD_DIM = D_MODEL // ML_HEADS
ML_WIDTH = ML_HEADS * ML_HEAD_DIM
ML_CHUNK = 64
CONV_W = 4
D_FF = -(-8 * D_MODEL // (3 * 256)) * 256
EPS = 1e-6
IN_SPLITS = (GM_WIDTH, GM_WIDTH, ML_WIDTH, ML_WIDTH, ML_WIDTH, ML_WIDTH, ML_HEADS, ML_HEADS, D_MODEL, D_MODEL)
IN_COLS = sum(IN_SPLITS)

kernel_name = "gated_gmlp_mlstm_hybrid_step"


def rmsnorm(x, g):
    xf = x.astype(jnp.float32)
    y = xf * lax.rsqrt(jnp.mean(xf * xf, axis=-1, keepdims=True) + EPS)
    return y.astype(x.dtype) * g


def layernorm(x, g, b):
    xf = x.astype(jnp.float32)
    mu = jnp.mean(xf, axis=-1, keepdims=True)
    var = jnp.mean(jnp.square(xf - mu), axis=-1, keepdims=True)
    return ((xf - mu) * lax.rsqrt(var + EPS)).astype(x.dtype) * g + b


def head_norm(h, g):
    mu = jnp.mean(h, axis=-1, keepdims=True)
    var = jnp.mean(jnp.square(h - mu), axis=-1, keepdims=True)
    return (h - mu) * lax.rsqrt(var + EPS) * g.reshape(ML_HEADS, ML_HEAD_DIM).astype(jnp.float32)


def gmlp_spatial(u, v, w_s, b_s, L):
    B, T, W = v.shape
    n_chunks = T // L
    ws = jnp.tril(w_s[:, :L, :L])
    vb = v.reshape(B, n_chunks, L, GM_GROUPS, W // GM_GROUPS)
    s = jnp.einsum('gts,bnsgc->bntgc', ws, vb) + b_s[:, :L].T[None, None, :, :, None]
    return u * s.reshape(B, T, W)


def causal_conv(xp, w, b, T):
    out = b
    for j in range(CONV_W):
        out = out + w[j] * xp[:, j:j + T]
    return out


def mlstm_chunkwise(q, k, v, i_pre, logf, C0, n0, m0, L):
    B, T, H, DH = q.shape
    N = T // L
    to_chunks = lambda a: a.reshape(B, N, L, H, DH).transpose(1, 0, 3, 2, 4)
    gate_chunks = lambda a: a.reshape(B, N, L, H).transpose(1, 0, 3, 2)
    mask = jnp.tril(jnp.ones((L, L), dtype=bool))

    def step(carry, inp):
        C, n, m = carry
        qc, kc, vc, ic, fc = inp
        bcum = jnp.cumsum(fc, axis=-1)
        dmat = bcum[..., :, None] - bcum[..., None, :] + ic[..., None, :]
        dmat = jnp.where(mask, dmat, -jnp.inf)
        inter = bcum + m[..., None]
        m_t = jnp.maximum(inter, jnp.max(dmat, axis=-1))
        w_inter = jnp.exp(inter - m_t)
        s = jnp.exp(dmat - m_t[..., None]) * jnp.einsum('bhtd,bhsd->bhts', qc, kc)
        num = w_inter[..., None] * jnp.einsum('bhvd,bhtd->bhtv', C, qc) + jnp.einsum('bhts,bhsv->bhtv', s, vc)
        den = w_inter * jnp.einsum('bhd,bhtd->bht', n, qc) + jnp.sum(s, axis=-1)
        h = num / jnp.maximum(jnp.abs(den), jnp.exp(-m_t))[..., None]
        b_last = bcum[..., -1]
        tail = b_last[..., None] - bcum + ic
        m_new = jnp.maximum(b_last + m, jnp.max(tail, axis=-1))
        decay = jnp.exp(b_last + m - m_new)
        w_in = jnp.exp(tail - m_new[..., None])
        C_new = decay[..., None, None] * C + jnp.einsum('bhs,bhsv,bhsd->bhvd', w_in, vc, kc)
        n_new = decay[..., None] * n + jnp.einsum('bhs,bhsd->bhd', w_in, kc)
        return (C_new, n_new, m_new), h

    (C, n, m), h = lax.scan(step, (C0, n0, m0),
                            (to_chunks(q), to_chunks(k), to_chunks(v), gate_chunks(i_pre), gate_chunks(logf)))
    h = h.transpose(1, 0, 3, 2, 4).reshape(B, T, H, DH)
    return h, C, n, m


def hybrid_layer(x, conv_state, C0, n0, m0, gm_chunk, ml_chunk,
                 g_norm1, w_in, b_i, b_f, ln_g, ln_b, w_s, b_s, conv_w, conv_b, hn_g,
                 b_gate, w_proj_a, w_proj_b, w_out, g_norm2, w_ffn_in, w_ffn_out):
    B, T, _ = x.shape
    h = rmsnorm(x, g_norm1)
    z = h @ w_in
    bounds = np.cumsum(IN_SPLITS)[:-1].tolist()
    u_gm, v_gm, q_raw, k_raw, v_ml, o_ml, i_raw, f_raw, ga, gb = jnp.split(z, bounds, axis=-1)

    u = jax.nn.gelu(u_gm, approximate=False)
    v_n = layernorm(jax.nn.gelu(v_gm, approximate=False), ln_g, ln_b)
    a_out = gmlp_spatial(u, v_n, w_s, b_s, gm_chunk)

    qk_raw = jnp.concatenate([q_raw, k_raw], axis=-1)
    qk_pad = jnp.concatenate([conv_state.astype(qk_raw.dtype), qk_raw], axis=1)
    conv_new = qk_pad[:, -(CONV_W - 1):]
    qk = jax.nn.silu(causal_conv(qk_pad, conv_w, conv_b, T))
    q = qk[..., :ML_WIDTH].reshape(B, T, ML_HEADS, ML_HEAD_DIM).astype(jnp.float32)
    k = (qk[..., ML_WIDTH:].reshape(B, T, ML_HEADS, ML_HEAD_DIM).astype(jnp.float32)
         * (ML_HEAD_DIM ** -0.5))
    vm = v_ml.reshape(B, T, ML_HEADS, ML_HEAD_DIM).astype(jnp.float32)
    i_pre = (i_raw + b_i).astype(jnp.float32)
    logf = jax.nn.log_sigmoid((f_raw + b_f).astype(jnp.float32))
    hm, C, n, m = mlstm_chunkwise(q, k, vm, i_pre, logf,
                                  C0.astype(jnp.float32), n0.astype(jnp.float32), m0.astype(jnp.float32),
                                  ml_chunk)
    hm = head_norm(hm, hn_g).reshape(B, T, ML_WIDTH).astype(x.dtype)
    b_out = jax.nn.sigmoid(o_ml) * hm

    merged = (jax.nn.sigmoid(ga + b_gate[0]) * (a_out @ w_proj_a)
              + jax.nn.sigmoid(gb + b_gate[1]) * (b_out @ w_proj_b))
    x = x + merged @ w_out

    h2 = rmsnorm(x, g_norm2)
    gt, up = jnp.split(h2 @ w_ffn_in, 2, axis=-1)
    x = x + (jax.nn.silu(gt) * up) @ w_ffn_out
    return x, v_n, conv_new, C, n, m


def setup_inputs(seed: int = 0) -> dict:
    key = jax.random.key(seed)
    ks = jax.random.split(key, 32)
    nrm = lambda k, shape, s: jax.random.normal(k, shape, jnp.float32) * s
    f32 = jnp.float32
    inputs = {
        "x_prompt": nrm(ks[0], (BATCH, SEQ, D_MODEL), 1.0),
        "x_sample": nrm(ks[1], (DEC_BATCH, DEC_SEQ, D_MODEL), 1.0),
        "state_conv": nrm(ks[2], (DEPTH, DEC_BATCH, CONV_W - 1, 2 * ML_WIDTH), 1.0),
        "state_C": nrm(ks[3], (DEPTH, DEC_BATCH, ML_HEADS, ML_HEAD_DIM, ML_HEAD_DIM), ML_HEAD_DIM ** -0.5),
        "state_n": nrm(ks[4], (DEPTH, DEC_BATCH, ML_HEADS, ML_HEAD_DIM), 0.5),
        "state_m": nrm(ks[5], (DEPTH, DEC_BATCH, ML_HEADS), 1.0),
        "g_norm1": 1.0 + nrm(ks[6], (DEPTH, D_MODEL), 0.02),
        "w_in": nrm(ks[7], (DEPTH, D_MODEL, IN_COLS), D_MODEL ** -0.5),
        "b_i": nrm(ks[8], (DEPTH, ML_HEADS), 0.1),
        "b_f": jnp.linspace(3.0, 6.0, ML_HEADS, dtype=f32)[None, :] + nrm(ks[9], (DEPTH, ML_HEADS), 0.1),
        "ln_g": 1.0 + nrm(ks[10], (DEPTH, GM_WIDTH), 0.02),
        "ln_b": nrm(ks[11], (DEPTH, GM_WIDTH), 0.02),
        "w_s": nrm(ks[12], (DEPTH, GM_GROUPS, GM_CHUNK, GM_CHUNK), GM_CHUNK ** -0.5),
        "b_s": 1.0 + nrm(ks[13], (DEPTH, GM_GROUPS, GM_CHUNK), 0.02),
        "conv_w": nrm(ks[14], (DEPTH, CONV_W, 2 * ML_WIDTH), CONV_W ** -0.5),
        "conv_b": nrm(ks[15], (DEPTH, 2 * ML_WIDTH), 0.02),
        "hn_g": 1.0 + nrm(ks[16], (DEPTH, ML_WIDTH), 0.02),
        "b_gate": nrm(ks[17], (DEPTH, 2, D_MODEL), 0.02),
        "w_proj_a": nrm(ks[18], (DEPTH, GM_WIDTH, D_MODEL), GM_WIDTH ** -0.5),
        "w_proj_b": nrm(ks[19], (DEPTH, ML_WIDTH, D_MODEL), ML_WIDTH ** -0.5),
        "w_out": nrm(ks[20], (DEPTH, D_MODEL, D_MODEL), D_MODEL ** -0.5),
        "g_norm2": 1.0 + nrm(ks[21], (DEPTH, D_MODEL), 0.02),
        "w_ffn_in": nrm(ks[22], (DEPTH, D_MODEL, 2 * D_FF), D_MODEL ** -0.5),
        "w_ffn_out": nrm(ks[23], (DEPTH, D_FF, D_MODEL), D_FF ** -0.5),
        "g_final": 1.0 + nrm(ks[24], (D_MODEL,), 0.02),
    }
    return inputs


def reference(x_prompt, x_sample, state_conv, state_C, state_n, state_m,
              g_norm1, w_in, b_i, b_f, ln_g, ln_b, w_s, b_s, conv_w, conv_b, hn_g,
              b_gate, w_proj_a, w_proj_b, w_out, g_norm2, w_ffn_in, w_ffn_out, g_final):
    Bp, Tp, _ = x_prompt.shape
    Ts = x_sample.shape[1]
    xp, xs = x_prompt, x_sample
    conv_p, C_p, n_p, m_p = [], [], [], []
    conv_s, C_s, n_s, m_s, v_s = [], [], [], [], []
    for l in range(DEPTH):
        w = (g_norm1[l], w_in[l], b_i[l], b_f[l], ln_g[l], ln_b[l], w_s[l], b_s[l], conv_w[l], conv_b[l],
             hn_g[l], b_gate[l], w_proj_a[l], w_proj_b[l], w_out[l], g_norm2[l], w_ffn_in[l], w_ffn_out[l])
        zc = jnp.zeros((Bp, CONV_W - 1, 2 * ML_WIDTH), xp.dtype)
        zC = jnp.zeros((Bp, ML_HEADS, ML_HEAD_DIM, ML_HEAD_DIM), jnp.float32)
        zn = jnp.zeros((Bp, ML_HEADS, ML_HEAD_DIM), jnp.float32)
        zm = jnp.zeros((Bp, ML_HEADS), jnp.float32)
        xp, _, cp, Cp, np_, mp = hybrid_layer(xp, zc, zC, zn, zm, GM_CHUNK, min(ML_CHUNK, Tp), *w)
        xs, vgs, cs, Cs, ns, ms = hybrid_layer(xs, state_conv[l], state_C[l], state_n[l], state_m[l],
                                               Ts, Ts, *w)
        conv_p.append(cp); C_p.append(Cp.astype(state_C.dtype)); n_p.append(np_.astype(state_n.dtype))
        m_p.append(mp.astype(state_m.dtype))
        conv_s.append(cs); C_s.append(Cs.astype(state_C.dtype)); n_s.append(ns.astype(state_n.dtype))
        m_s.append(ms.astype(state_m.dtype)); v_s.append(vgs)
    y_prompt = rmsnorm(xp, g_final)
    y_sample = rmsnorm(xs, g_final)
    return (y_prompt, y_sample,
            jnp.stack(conv_p), jnp.stack(C_p), jnp.stack(n_p), jnp.stack(m_p),
            jnp.stack(conv_s), jnp.stack(C_s), jnp.stack(n_s), jnp.stack(m_s), jnp.stack(v_s))
```

```cpp
#include <hip/hip_runtime.h>
#include <hip/hip_cooperative_groups.h>
#include <cstdio>
namespace cg = cooperative_groups;

#define LAS __attribute__((address_space(3)))
#define GAS __attribute__((address_space(1)))
typedef unsigned short bf16_t;
typedef short bf16x8 __attribute__((ext_vector_type(8)));
typedef float f32x4 __attribute__((ext_vector_type(4)));
typedef float f32x2 __attribute__((ext_vector_type(2)));
typedef unsigned u32x4 __attribute__((ext_vector_type(4)));
typedef unsigned u32x2 __attribute__((ext_vector_type(2)));

constexpr int D = 1024, NP = 16384, NS = 512, MT = NP + NS;
constexpr int SEQ = 2048, NB_P = 8, NB_S = 128, TS = 4;
constexpr int INC = 8200, DFF = 2816, NZ = 8192;
constexpr float EPS = 1e-6f;
constexpr int NWAVES = 8, NT = 512;
constexpr int LDS_BYTES = 139264;

constexpr size_t O_Y = 0, O_CONVP = 17301504, O_CP = 17350656, O_NP = 19447808, O_MP = 19456000,
                 O_CONVS = 19456032, O_CS = 20242464, O_NS = 53796896, O_MS = 53927968, O_GMV = 53928480;

constexpr size_t RSZ = (size_t)MT * D * 2;
constexpr size_t WS_CTL = 0;
constexpr size_t WS_PCNT = 16384;
constexpr size_t WS_WZ = 32768;
constexpr size_t WS_WPA = WS_WZ + (size_t)NZ * D * 2;
constexpr size_t WS_WPB = WS_WPA + (size_t)D * D * 2;
constexpr size_t WS_WO = WS_WPB + (size_t)D * D * 2;
constexpr size_t WS_WF1 = WS_WO + (size_t)D * D * 2;
constexpr size_t WS_WF2 = WS_WF1 + (size_t)2 * DFF * D * 2;
constexpr size_t WS_WSB = WS_WF2 + (size_t)D * DFF * 2;
constexpr size_t WS_G = WS_WSB + 4 * 128 * 128 * 2;
constexpr size_t WS_DEN = WS_G + (size_t)MT * 8 * 4;
constexpr size_t WS_H = WS_DEN + (size_t)MT * 4 * 4;
constexpr size_t WS_Z = WS_H + RSZ;
constexpr size_t WS_AOUT = WS_Z + 8 * RSZ;
constexpr size_t WS_BOUT = WS_AOUT + RSZ;
constexpr size_t WS_HM = WS_BOUT + RSZ;
constexpr size_t WS_QKC = WS_HM + RSZ;
constexpr size_t WS_GP = WS_QKC + 2 * RSZ;
constexpr size_t WS_XS = WS_GP + (size_t)NP * 4 * 16;
constexpr size_t WS_END = WS_XS + (size_t)NP * 4 * 4;

struct Params {
    const float *x_prompt, *x_sample, *state_conv, *state_C, *state_n, *state_m;
    const float *g_norm1, *w_in, *b_i, *b_f, *ln_g, *ln_b, *w_s, *b_s, *conv_w, *conv_b, *hn_g, *b_gate;
    const float *w_proj_a, *w_proj_b, *w_out, *g_norm2, *w_ffn_in, *w_ffn_out, *g_final;
    float* out; unsigned char* ws;
};

__device__ __forceinline__ unsigned pk2(float lo, float hi) { unsigned r; asm volatile("v_cvt_pk_bf16_f32 %0, %1, %2" : "=v"(r) : "v"(lo), "v"(hi)); return r; }
__device__ __forceinline__ float bflo(unsigned w) { return __uint_as_float(w << 16); }
__device__ __forceinline__ float bfhi(unsigned w) { return __uint_as_float(w & 0xffff0000u); }
__device__ __forceinline__ float wave_sum(float v) {
#pragma unroll
    for (int o = 1; o < 64; o <<= 1) v += __shfl_xor(v, o);
    return v;
}
__device__ __forceinline__ float sigmoid_f(float x) { return __builtin_amdgcn_rcpf(1.0f + __expf(-x)); }
__device__ __forceinline__ float silu_f(float x) { return x * sigmoid_f(x); }
#define LDS_BARRIER() do { asm volatile("s_waitcnt lgkmcnt(0)" ::: "memory"); __builtin_amdgcn_s_barrier(); asm volatile("" ::: "memory"); } while (0)
__device__ __forceinline__ void lds_fence() { asm volatile("s_waitcnt lgkmcnt(0)" ::: "memory"); }


#define XB_TMO      128
#define XB_XCNT(j)  (256  + 64 * (j))
#define XB_XSUB(j)  (1280 + 64 * (j))
#define XB_XGEN(j)  (2304 + 64 * (j))
#define XB_TOP      3328
#define XB_TOPGEN   3392
#define XCD_BAR_WORDS 3456
#define XB_SPIN_CAP (1u << 20)
__device__ __forceinline__ unsigned xb_ld(unsigned* p)              { return __hip_atomic_load(p, __ATOMIC_RELAXED, __HIP_MEMORY_SCOPE_AGENT); }
__device__ __forceinline__ unsigned xb_add(unsigned* p, unsigned v) { return __hip_atomic_fetch_add(p, v, __ATOMIC_RELAXED, __HIP_MEMORY_SCOPE_AGENT); }
__device__ __forceinline__ unsigned xb_xcc_id() { return (unsigned)__builtin_amdgcn_s_getreg((3 << 11) | 20) & 0xFu; }
#define XB_SPIN(cond, bar) do { unsigned _sp = 0; while (cond) { __builtin_amdgcn_s_sleep(1); \
    if ((++_sp & 255u) == 0u) { if (xb_ld(&(bar)[XB_TMO])) break; if (_sp > XB_SPIN_CAP) { atomicAdd(&(bar)[XB_TMO], 1u); break; } } } } while (0)
struct XcdBarrier { unsigned* bar; unsigned x; volatile LAS unsigned* st; };
__device__ __forceinline__ XcdBarrier xcd_barrier_post(unsigned* bar, volatile LAS unsigned* st) {
    XcdBarrier b; b.bar = bar; b.x = xb_xcc_id(); b.st = st;
    if (threadIdx.x == 0) (void)xb_add(&bar[XB_XCNT(b.x)], 1u);
    return b;
}
__device__ __forceinline__ void xcd_barrier_complete(unsigned* bar, unsigned x, unsigned& nloc, unsigned& nx) {
    const unsigned G = gridDim.x * gridDim.y * gridDim.z;
    unsigned sum, cnt, mine, sp = 0u;
    for (;;) {
        sum = 0u; cnt = 0u; mine = 0u;
#pragma unroll
        for (unsigned j = 0; j < 16; ++j) { const unsigned c = xb_ld(&bar[XB_XCNT(j)]); sum += c; cnt += (c > 0u) ? 1u : 0u; mine = (j == x) ? c : mine; }
        if (sum == G) break;
        __builtin_amdgcn_s_sleep(1);
        if ((++sp & 255u) == 0u) { if (xb_ld(&bar[XB_TMO])) break; if (sp > XB_SPIN_CAP) { atomicAdd(&bar[XB_TMO], 1u); break; } }
    }
    nloc = mine > 0u ? mine : 1u; nx = cnt > 0u ? cnt : 1u;
}
__device__ __forceinline__ void xcd_barrier(const XcdBarrier& b) {
    asm volatile("s_waitcnt vmcnt(0)" ::: "memory");
    __syncthreads();
    if (threadIdx.x == 0) {
        unsigned* bar = b.bar;
        __builtin_amdgcn_s_waitcnt(0);
        unsigned nloc = b.st[0], nx = b.st[1];
        if (nloc == 0u) { xcd_barrier_complete(bar, b.x, nloc, nx); b.st[0] = nloc; b.st[1] = nx; }
        const unsigned old = xb_add(&bar[XB_XSUB(b.x)], 1u);
        const unsigned gen = old / nloc;
        if (old + 1u == (gen + 1u) * nloc) {
            __builtin_amdgcn_fence(__ATOMIC_RELEASE, "agent");
            asm volatile("s_waitcnt vmcnt(0)" ::: "memory");
            const unsigned og = xb_add(&bar[XB_TOP], 1u);
            const unsigned tg = og / nx;
            if (og + 1u == (tg + 1u) * nx) xb_add(&bar[XB_TOPGEN], 1u);
            else XB_SPIN(xb_ld(&bar[XB_TOPGEN]) == tg, bar);
            __builtin_amdgcn_fence(__ATOMIC_ACQUIRE, "agent");
            xb_add(&bar[XB_XGEN(b.x)], 1u);
            asm volatile("s_waitcnt vmcnt(0)" ::: "memory");
        } else {
            XB_SPIN(xb_ld(&bar[XB_XGEN(b.x)]) == gen, bar);
            __builtin_amdgcn_fence(__ATOMIC_ACQUIRE, "agent");
            asm volatile("s_waitcnt vmcnt(0)" ::: "memory");
        }
    }
    __syncthreads();
}

template <int K>
__device__ __forceinline__ void small_tile_mma(const bf16_t* A, const bf16_t* Bt, int r0, int c0, int wid, int fr, int fq, f32x4 (&acc)[4][2]) {
    constexpr int KS = K / 8;
    const bf16_t* ap = A + (size_t)(r0 + fr) * K + wid * KS + 8 * fq;
    const bf16_t* bp = Bt + (size_t)(c0 + fr) * K + wid * KS + 8 * fq;
#pragma unroll 2
    for (int ks = 0; ks < KS; ks += 32) {
        bf16x8 a[4], b[2];
#pragma unroll
        for (int mi = 0; mi < 4; ++mi) a[mi] = *(const GAS bf16x8*)(ap + (size_t)(16 * mi) * K + ks);
#pragma unroll
        for (int ni = 0; ni < 2; ++ni) b[ni] = *(const GAS bf16x8*)(bp + (size_t)(16 * ni) * K + ks);
#pragma unroll
        for (int mi = 0; mi < 4; ++mi)
#pragma unroll
            for (int ni = 0; ni < 2; ++ni) acc[mi][ni] = __builtin_amdgcn_mfma_f32_16x16x32_bf16(b[ni], a[mi], acc[mi][ni], 0, 0, 0);
    }
}
__device__ __forceinline__ f32x4 small_tile_reduce(LAS unsigned char* lds, const f32x4 (&acc)[4][2], int wid, int fr, int fq) {
    LAS float* RED = (LAS float*)lds;
    __syncthreads();
#pragma unroll
    for (int mi = 0; mi < 4; ++mi)
#pragma unroll
        for (int ni = 0; ni < 2; ++ni) *(LAS f32x4*)(RED + (wid * 64 + 16 * mi + fr) * 32 + 16 * ni + 4 * fq) = acc[mi][ni];
    __syncthreads();
    const int tid = threadIdx.x, row = tid >> 3, cq = tid & 7;
    f32x4 s = (f32x4){0.f, 0.f, 0.f, 0.f};
#pragma unroll
    for (int w = 0; w < 8; ++w) s += *(const LAS f32x4*)(RED + (w * 64 + row) * 32 + 4 * cq);
    return s;
}
#define ZERO_ACC42(acc) _Pragma("unroll") for (int _m = 0; _m < 4; ++_m) _Pragma("unroll") for (int _n = 0; _n < 2; ++_n) acc[_m][_n] = (f32x4){0.f, 0.f, 0.f, 0.f}

namespace pg8 {
constexpr int BM = 256, BK = 64, HALF = 128, HTB = HALF * BK * 2, STAGE_BYTES = 8 * HTB, NXCD = 8, WGM = 8;
__device__ __forceinline__ int lds_byte(int r, int c) { const int st = (r >> 4) * 2 + (c >> 5), rr = r & 15, cc = c & 31, ob = rr * 64 + cc * 2; return st * 1024 + (ob ^ (((ob >> 9) & 1) << 5)); }
__device__ __forceinline__ void stage_rc(int b, int& R, int& C) { const int st = b / 1024, sb = b % 1024, swz = sb ^ (((sb >> 9) & 1) << 5); R = (st >> 1) * 16 + swz / 64; C = (st & 1) * 32 + (swz % 64) / 2; }
__device__ __forceinline__ int perm32(int rho) { const int n = rho >> 4, i = rho & 15; return 8 * (i >> 2) + 4 * n + (i & 3); }
struct Unit { int pm, pn; };
struct Gemm { const bf16_t* A; const bf16_t* Bt; int M, N, K; };
struct StaticOrder {
    int nM, nN, nwg, G, c;
    __device__ void init(int M, int N, int G_, int c_) { nM = M / BM; nN = N / BM; nwg = nM * nN; G = G_; c = c_; }
    __device__ bool next(int i, Unit& u) const {
        const long L = (long)i * G + c; if (L >= nwg) return false;
        int wgid = (int)L; { const int q = nwg / NXCD, r = nwg % NXCD, xcd = wgid % NXCD, off = wgid / NXCD; wgid = (xcd < r ? xcd * (q + 1) : r * (q + 1) + (xcd - r) * q) + off; }
        const int nig = WGM * nN, gid = wgid / nig, fm = gid * WGM, gsz = (nM - fm) < WGM ? (nM - fm) : WGM;
        u.pm = fm + ((wgid % nig) % gsz); u.pn = (wgid % nig) / gsz; return true;
    }
    __device__ __forceinline__ void a_ready(const Unit&) const {}
    __device__ __forceinline__ void done(const Unit&) const {}
};

template <class Epi, class Sched>
__device__ __forceinline__ void gemm_phase(LAS unsigned char* lds, const Gemm g, const Sched& S, const Epi& E) {
    const int tid = threadIdx.x, wid = __builtin_amdgcn_readfirstlane(tid >> 6), lane = tid & 63, wr = wid >> 2, wc = wid & 3, fr = lane & 15, fq = lane >> 4;
    const int K = g.K, nt = K / BK;
    unsigned voffA[2], voffB[2];
#pragma unroll
    for (int i = 0; i < 2; ++i) { int R, C; stage_rc(tid * 16 + i * 8192, R, C); const int Rb = Epi::PERM ? ((R & ~31) + perm32(R & 31)) : R;
        voffA[i] = (unsigned)(R * K + C) * 2u; voffB[i] = (unsigned)(Rb * K + C) * 2u; }
    const size_t kstep = (size_t)(BK * 2);
    const size_t hstep = (size_t)HALF * K * 2;
    const size_t tstep = 2 * hstep;
    const unsigned ldsw = (unsigned)wid * 1024u;
    const int aoff = lds_byte(wr * 64 + fr, fq * 8), boff = lds_byte(wc * 32 + fr, fq * 8);
#define PG8_SA(b, h) (((b) * 2 + (h)) * HTB)
#define PG8_SB(b, h) ((4 + (b) * 2 + (h)) * HTB)
#define PG8_STAGE(bufoff, gbase, voff) do { _Pragma("unroll") for (int _i = 0; _i < 2; ++_i) \
        __builtin_amdgcn_global_load_lds((const unsigned*)((const char*)(gbase) + (voff)[_i]), (LAS unsigned*)(lds + (bufoff) + ldsw + _i * 8192), 16, 0, 0); } while (0)
#define PG8_LDA(dst, b, h) do { _Pragma("unroll") for (int m = 0; m < 4; ++m) _Pragma("unroll") for (int k = 0; k < 2; ++k) dst[m][k] = *(const LAS bf16x8*)(lds + PG8_SA(b, h) + aoff + m * 2048 + k * 1024); } while (0)
#define PG8_LDB(dst, b, h) do { _Pragma("unroll") for (int n = 0; n < 2; ++n) _Pragma("unroll") for (int k = 0; k < 2; ++k) dst[n][k] = *(const LAS bf16x8*)(lds + PG8_SB(b, h) + boff + n * 2048 + k * 1024); } while (0)
#define PG8_MMA(ai, bj, At, Bt) do { __builtin_amdgcn_s_setprio(1); _Pragma("unroll") for (int m = 0; m < 4; ++m) _Pragma("unroll") for (int n = 0; n < 2; ++n) _Pragma("unroll") for (int k = 0; k < 2; ++k) \
        acc[ai][bj][m][n] = __builtin_amdgcn_mfma_f32_16x16x32_bf16(Bt[n][k], At[m][k], acc[ai][bj][m][n], 0, 0, 0); __builtin_amdgcn_s_setprio(0); } while (0)
#define PG8_WAIT_V(n) asm volatile("s_waitcnt vmcnt(" #n ")" ::: "memory")
#define PG8_WAIT_L(n) asm volatile("s_waitcnt lgkmcnt(" #n ")" ::: "memory")
#define PG8_BAR __builtin_amdgcn_s_barrier()
#define PG8_SCHED __builtin_amdgcn_sched_barrier(0)
    Unit cur, nxt; int ui = 0;
    if (!S.next(0, cur)) return;
    f32x4 acc[2][2][4][2];
#pragma unroll
    for (int a = 0; a < 2; ++a)
#pragma unroll
        for (int b = 0; b < 2; ++b)
#pragma unroll
            for (int m = 0; m < 4; ++m)
#pragma unroll
                for (int n = 0; n < 2; ++n) acc[a][b][m][n] = (f32x4){0.f, 0.f, 0.f, 0.f};
    bf16x8 At[4][2], B0[2][2], B1[2][2];
    const char* cA = (const char*)g.A + (size_t)cur.pm * tstep; const char* cB = (const char*)g.Bt + (size_t)cur.pn * tstep;
    S.a_ready(cur);
    PG8_STAGE(PG8_SB(0, 0), cB, voffB); PG8_STAGE(PG8_SA(0, 0), cA, voffA); PG8_STAGE(PG8_SB(0, 1), cB + hstep, voffB); PG8_STAGE(PG8_SA(0, 1), cA + hstep, voffA);
    if (wr == 1) PG8_BAR;
    PG8_WAIT_V(4); PG8_BAR;
    PG8_STAGE(PG8_SB(1, 0), cB + kstep, voffB); PG8_STAGE(PG8_SA(1, 0), cA + kstep, voffA); PG8_STAGE(PG8_SB(1, 1), cB + hstep + kstep, voffB);
    PG8_WAIT_V(6); PG8_BAR;
    for (;;) {
        const bool has_next = S.next(ui + 1, nxt);
        const char* nA = has_next ? (const char*)g.A + (size_t)nxt.pm * tstep : cA; const char* nB = has_next ? (const char*)g.Bt + (size_t)nxt.pn * tstep : cB;
        for (int t = 0; t < nt; t += 2) {
            const bool last = (t == nt - 2);
            const char* a1 = cA + (size_t)(t + 1) * kstep;
            const char* a2 = last ? nA : cA + (size_t)(t + 2) * kstep; const char* b2 = last ? nB : cB + (size_t)(t + 2) * kstep;
            const char* a3 = a2 + kstep; const char* b3 = b2 + kstep;
            if (last && has_next) S.a_ready(nxt);
            PG8_LDB(B0, 0, 0); PG8_SCHED; PG8_LDA(At, 0, 0); PG8_STAGE(PG8_SA(1, 1), a1 + hstep, voffA);
            PG8_WAIT_L(8); PG8_BAR; PG8_WAIT_L(0); PG8_MMA(0, 0, At, B0); PG8_BAR; PG8_SCHED;
            PG8_LDB(B1, 0, 1); PG8_STAGE(PG8_SB(0, 0), b2, voffB);
            PG8_BAR; PG8_WAIT_L(0); PG8_MMA(0, 1, At, B1); PG8_BAR;
            PG8_LDA(At, 0, 1); PG8_STAGE(PG8_SA(0, 0), a2, voffA);
            PG8_BAR; PG8_WAIT_L(0); PG8_MMA(1, 0, At, B0); PG8_BAR; PG8_SCHED;
            PG8_STAGE(PG8_SB(0, 1), b2 + hstep, voffB);
            PG8_WAIT_V(6); PG8_BAR; PG8_MMA(1, 1, At, B1); PG8_BAR;
            PG8_LDB(B0, 1, 0); PG8_SCHED; PG8_LDA(At, 1, 0); PG8_STAGE(PG8_SA(0, 1), a2 + hstep, voffA);
            PG8_WAIT_L(8); PG8_BAR; PG8_WAIT_L(0); PG8_MMA(0, 0, At, B0); PG8_BAR; PG8_SCHED;
            PG8_LDB(B1, 1, 1); PG8_STAGE(PG8_SB(1, 0), b3, voffB);
            PG8_BAR; PG8_WAIT_L(0); PG8_MMA(0, 1, At, B1); PG8_BAR;
            PG8_LDA(At, 1, 1); PG8_STAGE(PG8_SA(1, 0), a3, voffA);
            PG8_BAR; PG8_WAIT_L(0); PG8_MMA(1, 0, At, B0); PG8_BAR; PG8_SCHED;
            PG8_STAGE(PG8_SB(1, 1), b3 + hstep, voffB);
            PG8_WAIT_V(6); PG8_BAR; PG8_MMA(1, 1, At, B1); PG8_BAR;
        }
        if constexpr (!Epi::AFTER_DRAIN) { E(acc, cur, wr, wc, fr, fq); S.done(cur); }
        if (!has_next) break;
#pragma unroll
        for (int a = 0; a < 2; ++a)
#pragma unroll
            for (int b = 0; b < 2; ++b)
#pragma unroll
                for (int m = 0; m < 4; ++m)
#pragma unroll
                    for (int n = 0; n < 2; ++n) acc[a][b][m][n] = (f32x4){0.f, 0.f, 0.f, 0.f};
        cur = nxt; cA = nA; cB = nB; ++ui;
    }
    PG8_WAIT_V(0);
    if (wr == 0) PG8_BAR;
    PG8_BAR;
    if constexpr (Epi::AFTER_DRAIN) { E.fused(acc, cur, wr, wc, fr, fq, lds, wid, lane); S.done(cur); }
#undef PG8_SA
#undef PG8_SB
#undef PG8_STAGE
#undef PG8_LDA
#undef PG8_LDB
#undef PG8_MMA
#undef PG8_WAIT_V
#undef PG8_WAIT_L
#undef PG8_BAR
#undef PG8_SCHED
}
}
using pg8::Unit; using pg8::HALF; using pg8::BM;

__device__ __forceinline__ f32x2 gelu_pk(f32x2 v) {
    const f32x2 av = __builtin_elementwise_abs(v), d = av * 0.2316418882f + 1.0f;
    f32x2 t; t.x = __builtin_amdgcn_rcpf(d.x); t.y = __builtin_amdgcn_rcpf(d.y);
    f32x2 q = t * 0.5307027145f + (-0.7265760135f); q = q * t + 0.7107068705f; q = q * t + (-0.142248368f); q = q * t + 0.127414796f; q = q * t;
    const f32x2 s = (v * v) * (-0.72134752044f);
    f32x2 e; e.x = __builtin_amdgcn_exp2f(s.x); e.y = __builtin_amdgcn_exp2f(s.y);
    const f32x2 m = v * (q * e), r = v - m;
    f32x2 o; o.x = v.x < 0.f ? m.x : r.x; o.y = v.y < 0.f ? m.y : r.y; return o;
}

struct EpiZ {
    static constexpr bool PERM = true, AFTER_DRAIN = false;
    bf16_t* Z; const float* b_gate;
    __device__ __forceinline__ void operator()(const f32x4 (&acc)[2][2][4][2], const Unit& u, int wr, int wc, int fr, int fq) const {
        const int sec = u.pn >> 2; int colt = (u.pn & 3) * BM; bf16_t* base; int ldc;
        if (sec == 2 || sec == 3) { base = Z + (size_t)2 * MT * D; ldc = 2 * D; colt += (sec - 2) * D; } else { base = Z + (size_t)sec * MT * D; ldc = D; }
        const int row0 = u.pm * BM + wr * 64 + fr, col0 = colt + wc * 32 + 8 * fq;
        const int gcol0 = (u.pn & 3) * BM + wc * 32 + 8 * fq;
        f32x4 bv[2][2];
#pragma unroll
        for (int bj = 0; bj < 2; ++bj)
#pragma unroll
            for (int n = 0; n < 2; ++n) bv[bj][n] = (sec >= 6) ? *(const GAS f32x4*)(b_gate + (sec - 6) * D + gcol0 + bj * HALF + 4 * n) : (f32x4){0.f, 0.f, 0.f, 0.f};
#pragma unroll
        for (int ai = 0; ai < 2; ++ai)
#pragma unroll
            for (int m = 0; m < 4; ++m) { bf16_t* rowp = base + (size_t)(row0 + ai * HALF + m * 16) * ldc + col0;
#pragma unroll
                for (int bj = 0; bj < 2; ++bj) { f32x4 v0 = acc[ai][bj][m][0] + bv[bj][0], v1 = acc[ai][bj][m][1] + bv[bj][1];
                    if (false) { }
                    else if (sec >= 6) {
#pragma unroll
                        for (int j = 0; j < 4; ++j) { v0[j] = sigmoid_f(v0[j]); v1[j] = sigmoid_f(v1[j]); } }
                    u32x4 w; w.x = pk2(v0[0], v0[1]); w.y = pk2(v0[2], v0[3]); w.z = pk2(v1[0], v1[1]); w.w = pk2(v1[2], v1[3]);
                    *(GAS u32x4*)(rowp + bj * HALF) = w; } }
    }
};
struct EpiT1 {
    static constexpr bool PERM = true, AFTER_DRAIN = false;
    bf16_t* T; const bf16_t* SG;
    __device__ __forceinline__ void operator()(const f32x4 (&acc)[2][2][4][2], const Unit& u, int wr, int wc, int fr, int fq) const {
        const int row0 = u.pm * BM + wr * 64 + fr, col0 = u.pn * BM + wc * 32 + 8 * fq;
#pragma unroll
        for (int ai = 0; ai < 2; ++ai)
#pragma unroll
            for (int m = 0; m < 4; ++m) { const size_t off = (size_t)(row0 + ai * HALF + m * 16) * D + col0;
#pragma unroll
                for (int bj = 0; bj < 2; ++bj) { const u32x4 s = *(const GAS u32x4*)(SG + off + bj * HALF);
                    const f32x4 o0 = acc[ai][bj][m][0], o1 = acc[ai][bj][m][1];
                    u32x4 w; w.x = pk2(o0[0] * bflo(s.x), o0[1] * bfhi(s.x)); w.y = pk2(o0[2] * bflo(s.y), o0[3] * bfhi(s.y));
                    w.z = pk2(o1[0] * bflo(s.z), o1[1] * bfhi(s.z)); w.w = pk2(o1[2] * bflo(s.w), o1[3] * bfhi(s.w));
                    *(GAS u32x4*)(T + off + bj * HALF) = w; } }
    }
};
struct EpiT2 {
    static constexpr bool PERM = true, AFTER_DRAIN = false;
    const bf16_t* T; const bf16_t* SG; bf16_t* O;
    __device__ __forceinline__ void operator()(const f32x4 (&acc)[2][2][4][2], const Unit& u, int wr, int wc, int fr, int fq) const {
        const int row0 = u.pm * BM + wr * 64 + fr, col0 = u.pn * BM + wc * 32 + 8 * fq;
#pragma unroll
        for (int ai = 0; ai < 2; ++ai)
#pragma unroll
            for (int m = 0; m < 4; ++m) { const size_t off = (size_t)(row0 + ai * HALF + m * 16) * D + col0;
#pragma unroll
                for (int bj = 0; bj < 2; ++bj) { const u32x4 s = *(const GAS u32x4*)(SG + off + bj * HALF), t = *(const GAS u32x4*)(T + off + bj * HALF);
                    const f32x4 o0 = acc[ai][bj][m][0], o1 = acc[ai][bj][m][1];
                    u32x4 w; w.x = pk2(bflo(t.x) + o0[0] * bflo(s.x), bfhi(t.x) + o0[1] * bfhi(s.x)); w.y = pk2(bflo(t.y) + o0[2] * bflo(s.y), bfhi(t.y) + o0[3] * bfhi(s.y));
                    w.z = pk2(bflo(t.z) + o1[0] * bflo(s.z), bfhi(t.z) + o1[1] * bfhi(s.z)); w.w = pk2(bflo(t.w) + o1[2] * bflo(s.w), bfhi(t.w) + o1[3] * bfhi(s.w));
                    *(GAS u32x4*)(O + off + bj * HALF) = w; } }
    }
};
template <bool FIRST> struct EpiRes {
    static constexpr bool PERM = true, AFTER_DRAIN = false;
    const float* xp; bf16_t* XB;
    __device__ __forceinline__ void operator()(const f32x4 (&acc)[2][2][4][2], const Unit& u, int wr, int wc, int fr, int fq) const {
        const int row0 = u.pm * BM + wr * 64 + fr, col0 = u.pn * BM + wc * 32 + 8 * fq;
#pragma unroll
        for (int ai = 0; ai < 2; ++ai)
#pragma unroll
            for (int m = 0; m < 4; ++m) { const size_t off = (size_t)(row0 + ai * HALF + m * 16) * D + col0;
#pragma unroll
                for (int bj = 0; bj < 2; ++bj) { f32x4 b0, b1;
                    if (FIRST) { b0 = *(const GAS f32x4*)(xp + off + bj * HALF); b1 = *(const GAS f32x4*)(xp + off + bj * HALF + 4); }
                    else { const u32x4 t = *(const GAS u32x4*)(XB + off + bj * HALF); b0 = (f32x4){bflo(t.x), bfhi(t.x), bflo(t.y), bfhi(t.y)}; b1 = (f32x4){bflo(t.z), bfhi(t.z), bflo(t.w), bfhi(t.w)}; }
                    const f32x4 o0 = b0 + acc[ai][bj][m][0], o1 = b1 + acc[ai][bj][m][1];
                    u32x4 w; w.x = pk2(o0[0], o0[1]); w.y = pk2(o0[2], o0[3]); w.z = pk2(o1[0], o1[1]); w.w = pk2(o1[2], o1[3]);
                    *(GAS u32x4*)(XB + off + bj * HALF) = w; } }
    }
};
template <bool FIRST> struct EpiNorm {
    static constexpr bool PERM = true, AFTER_DRAIN = true;
    const float* xp; bf16_t* XB; bf16_t* H2; float* Y; const float* gain; float* xs; unsigned* cnt; unsigned* tmo; unsigned want;
    __device__ __forceinline__ void fused(f32x4 (&acc)[2][2][4][2], const Unit& u, int wr, int wc, int fr, int fq, LAS unsigned char* lds, int wid, int lane) const {
        LAS float* P = (LAS float*)lds;
        LAS float* S = (LAS float*)(lds + 4096);
        const int row0 = u.pm * BM + wr * 64 + fr, col0 = u.pn * BM + wc * 32 + 8 * fq;
#pragma unroll
        for (int ai = 0; ai < 2; ++ai)
#pragma unroll
            for (int m = 0; m < 4; ++m) { const size_t off = (size_t)(row0 + ai * HALF + m * 16) * D + col0; float ss = 0.f;
#pragma unroll
                for (int bj = 0; bj < 2; ++bj) { f32x4& a0 = acc[ai][bj][m][0]; f32x4& a1 = acc[ai][bj][m][1];
                    if (FIRST) { a0 += *(const GAS f32x4*)(xp + off + bj * HALF); a1 += *(const GAS f32x4*)(xp + off + bj * HALF + 4);
                        u32x4 w; w.x = pk2(a0[0], a0[1]); w.y = pk2(a0[2], a0[3]); w.z = pk2(a1[0], a1[1]); w.w = pk2(a1[2], a1[3]); *(GAS u32x4*)(XB + off + bj * HALF) = w; }
                    else { const u32x4 t = *(const GAS u32x4*)(XB + off + bj * HALF);
                        a0[0] += bflo(t.x); a0[1] += bfhi(t.x); a0[2] += bflo(t.y); a0[3] += bfhi(t.y); a1[0] += bflo(t.z); a1[1] += bfhi(t.z); a1[2] += bflo(t.w); a1[3] += bfhi(t.w); }
                    ss += ((a0[0] * a0[0] + a0[1] * a0[1]) + (a0[2] * a0[2] + a0[3] * a0[3])) + ((a1[0] * a1[0] + a1[1] * a1[1]) + (a1[2] * a1[2] + a1[3] * a1[3])); }
                ss += __shfl_xor(ss, 16); ss += __shfl_xor(ss, 32);
                if (fq == 0) P[(ai * HALF + wr * 64 + m * 16 + fr) * 4 + wc] = ss; }
        asm volatile("s_waitcnt lgkmcnt(0)" ::: "memory"); __builtin_amdgcn_s_barrier(); asm volatile("" ::: "memory");
        const int row = wid * 32 + (lane & 31);
        if (lane < 32) { const f32x4 q = *(const LAS f32x4*)(P + row * 4);
            __hip_atomic_store(xs + ((size_t)(u.pm * BM + row) * 4 + u.pn), (q[0] + q[1]) + (q[2] + q[3]), __ATOMIC_RELAXED, __HIP_MEMORY_SCOPE_AGENT); }
        asm volatile("s_waitcnt vmcnt(0)" ::: "memory");
        if (lane == 0) (void)__hip_atomic_fetch_add(cnt + 64 * u.pm, 1u, __ATOMIC_RELAXED, __HIP_MEMORY_SCOPE_AGENT);
        if (wid == 0) { unsigned sp = 0;
            while ((unsigned)__builtin_amdgcn_readfirstlane(__hip_atomic_load(cnt + 64 * u.pm, __ATOMIC_RELAXED, __HIP_MEMORY_SCOPE_AGENT)) < want) {
                __builtin_amdgcn_s_sleep(2); if (++sp > (1u << 20)) { if (lane == 0) __hip_atomic_store(tmo, 1u, __ATOMIC_RELAXED, __HIP_MEMORY_SCOPE_AGENT); break; } }
            __builtin_amdgcn_fence(__ATOMIC_ACQUIRE, "agent"); }
        asm volatile("s_waitcnt vmcnt(0) lgkmcnt(0)" ::: "memory"); __builtin_amdgcn_s_barrier(); asm volatile("" ::: "memory");
        if (lane < 32) { const float* sl = xs + (size_t)(u.pm * BM + row) * 4; float t = 0.f;
#pragma unroll
            for (int j = 0; j < 4; ++j) t += __hip_atomic_load(sl + j, __ATOMIC_RELAXED, __HIP_MEMORY_SCOPE_AGENT);
            S[row] = rsqrtf(t * (1.0f / D) + EPS); }
        asm volatile("s_waitcnt vmcnt(0) lgkmcnt(0)" ::: "memory"); __builtin_amdgcn_s_barrier(); asm volatile("" ::: "memory");
        f32x4 gv[2][2];
#pragma unroll
        for (int bj = 0; bj < 2; ++bj) { gv[bj][0] = *(const GAS f32x4*)(gain + col0 + bj * HALF); gv[bj][1] = *(const GAS f32x4*)(gain + col0 + bj * HALF + 4); }
#pragma unroll
        for (int ai = 0; ai < 2; ++ai)
#pragma unroll
            for (int m = 0; m < 4; ++m) { const int r = ai * HALF + wr * 64 + m * 16 + fr; const float rs = S[r]; const size_t off = (size_t)(u.pm * BM + r) * D + col0;
#pragma unroll
                for (int bj = 0; bj < 2; ++bj) { const f32x4 o0 = acc[ai][bj][m][0] * rs * gv[bj][0], o1 = acc[ai][bj][m][1] * rs * gv[bj][1];
                    if (FIRST) { u32x4 w; w.x = pk2(o0[0], o0[1]); w.y = pk2(o0[2], o0[3]); w.z = pk2(o1[0], o1[1]); w.w = pk2(o1[2], o1[3]); *(GAS u32x4*)(H2 + off + bj * HALF) = w; }
                    else { *(GAS f32x4*)(Y + off + bj * HALF) = o0; *(GAS f32x4*)(Y + off + bj * HALF + 4) = o1; } } }
    }
};
struct EpiFfn {
    static constexpr bool PERM = true, AFTER_DRAIN = false;
    bf16_t* ACT;
    __device__ __forceinline__ void operator()(const f32x4 (&acc)[2][2][4][2], const Unit& u, int wr, int wc, int fr, int fq) const {
        const int row0 = u.pm * BM + wr * 64 + fr, col0 = u.pn * HALF + wc * 32 + 8 * fq;
#pragma unroll
        for (int ai = 0; ai < 2; ++ai)
#pragma unroll
            for (int m = 0; m < 4; ++m) { bf16_t* rowp = ACT + (size_t)(row0 + ai * HALF + m * 16) * DFF + col0;
                f32x4 o0, o1;
#pragma unroll
                for (int j = 0; j < 4; ++j) { o0[j] = silu_f(acc[ai][0][m][0][j]) * acc[ai][1][m][0][j]; o1[j] = silu_f(acc[ai][0][m][1][j]) * acc[ai][1][m][1][j]; }
                u32x4 w; w.x = pk2(o0[0], o0[1]); w.y = pk2(o0[2], o0[3]); w.z = pk2(o1[0], o1[1]); w.w = pk2(o1[2], o1[3]);
                *(u32x4*)rowp = w; }
    }
};

__device__ __forceinline__ void transpose_item(const float* W, int ldw, int K, bf16_t* WT, int k0, int srccol0, int dstrow0, LAS float* scr, int lane) {
    { const int kr = lane >> 3, nq = lane & 7;
      f32x4 wv[8];
#pragma unroll
      for (int i = 0; i < 8; ++i) wv[i] = *(const GAS f32x4*)(W + (size_t)(k0 + 8 * i + kr) * ldw + srccol0 + 4 * nq);
#pragma unroll
      for (int i = 0; i < 8; ++i) { LAS float* d = scr + (8 * i + kr) * 33 + 4 * nq; d[0] = wv[i][0]; d[1] = wv[i][1]; d[2] = wv[i][2]; d[3] = wv[i][3]; } }
    lds_fence();
    const int c = lane & 7;
#pragma unroll
    for (int j = 0; j < 4; ++j) { const int n = (lane >> 3) + 8 * j; const LAS float* s = scr + (8 * c) * 33 + n;
        u32x4 o; o.x = pk2(s[0 * 33], s[1 * 33]); o.y = pk2(s[2 * 33], s[3 * 33]); o.z = pk2(s[4 * 33], s[5 * 33]); o.w = pk2(s[6 * 33], s[7 * 33]);
        *(GAS u32x4*)(WT + (size_t)(dstrow0 + n) * K + k0 + 8 * c) = o; }
    lds_fence();
}

__device__ __forceinline__ void phase0(const Params& p, LAS unsigned char* lds) {
    const int tid = threadIdx.x, lane = tid & 63, wid = tid >> 6;
    const int gw = blockIdx.x * NWAVES + wid, NGW = gridDim.x * NWAVES;
    unsigned char* ws = p.ws;
    LAS float* scr = (LAS float*)(lds + wid * 8448);
    LAS float* gwl = (LAS float*)(lds + 69632);
    for (int i = tid; i < 8192; i += NT) { const int k = i >> 3, c = i & 7; gwl[c * 1024 + k] = p.w_in[(size_t)k * INC + 6144 + c]; }
    for (int it = gw; it < 16 * 256; it += NGW) { const int kb = it / 256, nb = it % 256, n0 = nb * 32; transpose_item(p.w_in, INC, D, (bf16_t*)(ws + WS_WZ), kb * 64, n0 < 6144 ? n0 : n0 + 8, n0, scr, lane); }
    { bf16_t* wsb = (bf16_t*)(ws + WS_WSB);
      for (int i = blockIdx.x * NT + tid; i < 4 * 128 * 128 / 2; i += gridDim.x * NT) { const int e = 2 * i, s = e & 127, t = (e >> 7) & 127;
          const float a = s <= t ? p.w_s[e] : 0.f, b = (s + 1) <= t ? p.w_s[e + 1] : 0.f; ((unsigned*)wsb)[i] = pk2(a, b); } }
    __syncthreads();
    bf16_t* H = (bf16_t*)(ws + WS_H); float* G = (float*)(ws + WS_G);
    f32x4 g1v[4];
#pragma unroll
    for (int j = 0; j < 4; ++j) g1v[j] = ((const GAS f32x4*)p.g_norm1)[lane + 64 * j];
    for (int row0 = gw; row0 < MT; row0 += 2 * NGW) {
        f32x4 vv[2][4];
#pragma unroll
        for (int rr = 0; rr < 2; ++rr) { const int row = (row0 + rr * NGW < MT) ? row0 + rr * NGW : row0;
            const GAS float* xr = row < NP ? (const GAS float*)p.x_prompt + (size_t)row * D : (const GAS float*)p.x_sample + (size_t)(row - NP) * D;
#pragma unroll
            for (int j = 0; j < 4; ++j) vv[rr][j] = ((const GAS f32x4*)xr)[lane + 64 * j]; }
#pragma unroll
        for (int rr = 0; rr < 2; ++rr) { const int row = row0 + rr * NGW; if (row < MT) {
            f32x4 v[4]; float ss = 0.f;
#pragma unroll
            for (int j = 0; j < 4; ++j) { v[j] = vv[rr][j]; ss += (v[j][0] * v[j][0] + v[j][1] * v[j][1]) + (v[j][2] * v[j][2] + v[j][3] * v[j][3]); }
            const float r = rsqrtf(wave_sum(ss) * (1.0f / D) + EPS);
#pragma unroll
            for (int j = 0; j < 4; ++j) { v[j] = v[j] * r * g1v[j];
                u32x2 o; o.x = pk2(v[j][0], v[j][1]); o.y = pk2(v[j][2], v[j][3]); ((GAS u32x2*)((GAS bf16_t*)H + (size_t)row * D))[lane + 64 * j] = o; }
            float ga[8];
#pragma unroll
            for (int c = 0; c < 8; ++c) { float a = 0.f;
#pragma unroll
                for (int j = 0; j < 4; ++j) { const f32x4 w4 = ((const LAS f32x4*)(gwl + c * 1024))[lane + 64 * j]; a += (v[j][0] * w4[0] + v[j][1] * w4[1]) + (v[j][2] * w4[2] + v[j][3] * w4[3]); }
                ga[c] = wave_sum(a); }
            if (lane == 0) {
#pragma unroll
                for (int c = 0; c < 4; ++c) G[(size_t)row * 8 + c] = ga[c] + p.b_i[c];
#pragma unroll
                for (int c = 0; c < 4; ++c) { const float xx = ga[4 + c] + p.b_f[c]; G[(size_t)row * 8 + 4 + c] = fminf(xx, 0.f) - log1pf(expf(-fabsf(xx))); }
            } } }
    }
}

constexpr int QS_LD = 264, CS_LD = 264;
constexpr int OFF_QS = 0, OFF_KK = 33792, OFF_VT = 70656, OFF_SS = 82176, OFF_CS = 91392, OFF_GT = 133632;

__device__ __forceinline__ void load_raw4(float (&r)[4], const bf16_t* QK, const float* sconv, int rel, size_t rowbase, int col) {
    if (rel >= 0) { const u32x2 w = *(const GAS u32x2*)(QK + (rowbase + rel) * (2 * D) + col);
        r[0] = bflo(w.x); r[1] = bfhi(w.x); r[2] = bflo(w.y); r[3] = bfhi(w.y); }
    else if (sconv) { const f32x4 a = *(const GAS f32x4*)(sconv + (size_t)(3 + rel) * (2 * D) + col);
        r[0] = a[0]; r[1] = a[1]; r[2] = a[2]; r[3] = a[3]; }
    else { r[0] = 0.f; r[1] = 0.f; r[2] = 0.f; r[3] = 0.f; }
}
__device__ __forceinline__ void conv_silu_4x4(u32x2 (&out)[4], const Params& p, const bf16_t* QK, const float* sconv, int rel0, size_t rowbase, int col, float scale) {
    f32x4 acc[4];
    { const f32x4 b0 = *(const GAS f32x4*)(p.conv_b + col);
#pragma unroll
      for (int i = 0; i < 4; ++i) acc[i] = b0; }
    f32x4 w[4];
#pragma unroll
    for (int j = 0; j < 4; ++j) w[j] = *(const GAS f32x4*)(p.conv_w + (size_t)j * 2 * D + col);
#pragma unroll
    for (int i = 0; i < 7; ++i) {
        float r[4]; load_raw4(r, QK, sconv, rel0 - 3 + i, rowbase, col);
#pragma unroll
        for (int tt = 0; tt < 4; ++tt) { const int j = i - tt; if (j >= 0 && j < 4) {
#pragma unroll
            for (int e = 0; e < 4; ++e) acc[tt][e] += w[j][e] * r[e]; } }
    }
#pragma unroll
    for (int i = 0; i < 4; ++i) {
#pragma unroll
        for (int e = 0; e < 4; ++e) acc[i][e] = silu_f(acc[i][e]) * scale;
        out[i].x = pk2(acc[i][0], acc[i][1]); out[i].y = pk2(acc[i][2], acc[i][3]); }
}

__device__ __forceinline__ void phase_conv(const Params& p) {
    int tid = threadIdx.x; asm volatile("" : "+v"(tid));
    unsigned char* ws = p.ws; asm volatile("" : "+s"(ws));
    const bf16_t* QK = (const bf16_t*)(ws + WS_Z + 2 * RSZ); bf16_t* QKC = (bf16_t*)(ws + WS_QKC);
    const int col = 4 * tid; const float sc = col < D ? 1.0f : 0.0625f;
    f32x4 w[4], bias = *(const GAS f32x4*)(p.conv_b + col);
#pragma unroll
    for (int j = 0; j < 4; ++j) w[j] = *(const GAS f32x4*)(p.conv_w + (size_t)j * 2 * D + col);
    for (int rg0 = blockIdx.x; rg0 < NP / 4; rg0 += 2 * gridDim.x) {
        u32x2 raw[2][7]; bool ok[2];
#pragma unroll
        for (int u = 0; u < 2; ++u) { const int rg = rg0 + u * gridDim.x; ok[u] = rg < NP / 4 && (rg & (SEQ / 4 - 1)) != 0; const int R = 4 * (ok[u] ? rg : (rg0 | 1));
#pragma unroll
            for (int i = 0; i < 7; ++i) raw[u][i] = ok[u] ? *(const GAS u32x2*)(QK + (size_t)(R - 3 + i) * (2 * D) + col) : (u32x2){0u, 0u}; }
#pragma unroll
        for (int u = 0; u < 2; ++u) if (ok[u]) { const int R = 4 * (rg0 + u * gridDim.x);
            f32x4 acc[4] = {bias, bias, bias, bias};
#pragma unroll
            for (int i = 0; i < 7; ++i) { const f32x4 r = (f32x4){bflo(raw[u][i].x), bfhi(raw[u][i].x), bflo(raw[u][i].y), bfhi(raw[u][i].y)};
#pragma unroll
                for (int tt = 0; tt < 4; ++tt) { const int j = i - tt; if (j >= 0 && j < 4) acc[tt] += w[j] * r; } }
#pragma unroll
            for (int i = 0; i < 4; ++i) { u32x2 o; o.x = pk2(silu_f(acc[i][0]) * sc, silu_f(acc[i][1]) * sc); o.y = pk2(silu_f(acc[i][2]) * sc, silu_f(acc[i][3]) * sc);
                *(GAS u32x2*)(QKC + (size_t)(R + i) * (2 * D) + col) = o; } }
    }
    for (int k = blockIdx.x; k < NB_P + NS / 4; k += gridDim.x) {
        const int rg = k < NB_P ? k * (SEQ / 4) : NP / 4 + (k - NB_P);
        const int R = 4 * rg; int rel0; size_t rowbase; const float* sconv;
        if (R < NP) { rel0 = R & (SEQ - 1); rowbase = (size_t)(R - rel0); sconv = nullptr; }
        else { rel0 = 0; rowbase = (size_t)R; sconv = p.state_conv + (size_t)((R - NP) >> 2) * 3 * 2 * D; }
        u32x2 o[4]; conv_silu_4x4(o, p, QK, sconv, rel0, rowbase, col, sc);
#pragma unroll
        for (int i = 0; i < 4; ++i) *(GAS u32x2*)(QKC + (size_t)(R + i) * (2 * D) + col) = o[i];
    }
}
__device__ __forceinline__ void phase_gate_scan(const Params& p) {
    int tid = threadIdx.x; asm volatile("" : "+v"(tid));
    const int lane = tid & 63, wid = tid >> 6, gw = blockIdx.x * NWAVES + wid, NGW = gridDim.x * NWAVES;
    const float* G = (const float*)(p.ws + WS_G); f32x4* GP = (f32x4*)(p.ws + WS_GP);
    for (int it = gw; it < (NP / 64) * 4; it += NGW) { const int c = it >> 2, h = it & 3; const size_t row = (size_t)c * 64 + lane;
        const float ic = G[row * 8 + h], fc = G[row * 8 + 4 + h];
        float bc = fc;
#pragma unroll
        for (int o = 1; o < 64; o <<= 1) { const float uu = __shfl_up(bc, o); if (lane >= o) bc += uu; }
        const float a = ic - bc; float pm = a;
#pragma unroll
        for (int o = 1; o < 64; o <<= 1) { const float uu = __shfl_up(pm, o); if (lane >= o) pm = fmaxf(pm, uu); }
        GP[row * 4 + h] = (f32x4){bc, a, pm, pm}; }
}

__device__ __forceinline__ void mlstm_gates_reg(LAS float* GT, f32x4 gp, float m_run, int lane) {
    LAS float* ROWT = GT; LAS float* COLT = GT + 64; LAS float* WINTER = GT + 128; LAS float* WIN = GT + 192; LAS float* DFLOOR = GT + 256; LAS float* MISC = GT + 320;
    const float bc = gp[0], a = gp[1], pm = fmaxf(gp[2], gp[3]);
    const float inter = bc + m_run, mt = fmaxf(inter, bc + pm);
    const float blast = __shfl(bc, 63), amax = __shfl(pm, 63);
    const float mnew = fmaxf(blast + m_run, blast + amax);
    ROWT[lane] = bc - mt; COLT[lane] = a; WINTER[lane] = __expf(inter - mt); WIN[lane] = __expf(blast + a - mnew); DFLOOR[lane] = __expf(-mt);
    if (lane == 0) { MISC[0] = __expf(blast + m_run - mnew); MISC[1] = mnew; }
}

__device__ __forceinline__ void mlstm_prompt_item(const Params& p, LAS unsigned char* lds, int b, int h, int js) {
    constexpr int TT = 4, LV = 64, NCH = 32, KSP = 64, SLD = KSP + 8;
    int tid = threadIdx.x; asm volatile("" : "+v"(tid));
    const int lane = tid & 63, wid = __builtin_amdgcn_readfirstlane(tid >> 6);
    unsigned char* ws = p.ws; asm volatile("" : "+s"(ws));
    const bf16_t* QKC = (const bf16_t*)(ws + WS_QKC); const bf16_t* VM = (const bf16_t*)(ws + WS_Z + 4 * RSZ);
    const GAS f32x4* GP = (const GAS f32x4*)(ws + WS_GP); GAS float* DEN = (GAS float*)(ws + WS_DEN); GAS bf16_t* HM = (GAS bf16_t*)(ws + WS_HM);
    const size_t rowbase = (size_t)b * SEQ;
    const int v0 = js * 64, dbase = wid * 32;
    LAS bf16_t* Qs = (LAS bf16_t*)(lds + OFF_QS); LAS bf16_t* KK = (LAS bf16_t*)(lds + OFF_KK); LAS bf16_t* VT = (LAS bf16_t*)(lds + OFF_VT);
    LAS bf16_t* Ss = (LAS bf16_t*)(lds + OFF_SS); LAS bf16_t* Cs = (LAS bf16_t*)(lds + OFF_CS); LAS float* GT = (LAS float*)(lds + OFF_GT);
    LAS float* ROWT = GT; LAS float* COLT = GT + 64; LAS float* WINTER = GT + 128; LAS float* WIN = GT + 192; LAS float* DFLOOR = GT + 256; LAS float* MISC = GT + 320;

    f32x4 C[5][2];
#pragma unroll
    for (int vi = 0; vi < 5; ++vi)
#pragma unroll
        for (int di = 0; di < 2; ++di) C[vi][di] = (f32x4){0.f, 0.f, 0.f, 0.f};
    float m_run = 0.f;
    __syncthreads();
    for (int i = tid; i < 80 * CS_LD / 2; i += NT) ((LAS unsigned*)Cs)[i] = 0u;
    for (int i = tid; i < 16 * KSP; i += NT) { const int rr = 64 + i / KSP, s = i % KSP; VT[rr * SLD + s] = (rr == 64) ? (bf16_t)0x3F80 : (bf16_t)0; }
    for (int i = tid; i < 64 * SLD / 2; i += NT) ((LAS unsigned*)Ss)[i] = 0u;

    u32x4 qr[4], kr[4], va, vc; f32x4 gpr;
    { const int dg = tid & 31, tp = tid >> 5, vg = tid & 7, sp = (tid >> 3) & 31;
#pragma unroll
      for (int i = 0; i < 4; ++i) { qr[i] = *(const GAS u32x4*)(QKC + (rowbase + 4 * tp + i) * (2 * D) + 256 * h + 8 * dg); kr[i] = *(const GAS u32x4*)(QKC + (rowbase + 4 * tp + i) * (2 * D) + D + 256 * h + 8 * dg); }
      va = *(const GAS u32x4*)(VM + (rowbase + 2 * sp) * D + 256 * h + v0 + 8 * vg); vc = *(const GAS u32x4*)(VM + (rowbase + 2 * sp + 1) * D + 256 * h + v0 + 8 * vg);
      gpr = GP[(rowbase + lane) * 4 + h]; }
    const int ns_t = (wid >= 4) ? 2 : (wid < 2 ? 1 : 0);
    const int sidx0 = (wid >= 4) ? 2 * (wid - 4) : 8 + wid;
    const int nn_t = (wid < 4) ? 3 : 2;

    for (int ch = 0; ch < NCH; ++ch) {
        int lt = tid; asm volatile("" : "+v"(lt));
        const int fr = lt & 15, fq = (lt >> 4) & 3, dg = lt & 31, tp = lt >> 5, vg = lt & 7, sp = (lt >> 3) & 31, ln = lt & 63;
        const size_t r0 = rowbase + (size_t)ch * LV;
        if (wid == 0) mlstm_gates_reg(GT, gpr, m_run, ln);
#pragma unroll
        for (int i = 0; i < 4; ++i) { *(LAS u32x4*)(Qs + (4 * tp + i) * QS_LD + 8 * dg) = qr[i]; *(LAS u32x4*)(KK + (4 * tp + i) * QS_LD + 8 * dg) = kr[i]; }
        if (lt < 256) { const unsigned aw[4] = {va.x, va.y, va.z, va.w}, cw[4] = {vc.x, vc.y, vc.z, vc.w};
#pragma unroll
            for (int e = 0; e < 4; ++e) { *(LAS unsigned*)(VT + (8 * vg + 2 * e) * SLD + 2 * sp) = (aw[e] & 0xffffu) | (cw[e] << 16);
                                          *(LAS unsigned*)(VT + (8 * vg + 2 * e + 1) * SLD + 2 * sp) = (aw[e] >> 16) | (cw[e] & 0xffff0000u); } }
        u32x4 kc[4];
#pragma unroll
        for (int i = 0; i < 4; ++i) kc[i] = kr[i];
        if (ch + 1 < NCH) { const size_t rn = r0 + LV;
            gpr = GP[(rn + ln) * 4 + h];
#pragma unroll
            for (int i = 0; i < 4; ++i) { qr[i] = *(const GAS u32x4*)(QKC + (rn + 4 * tp + i) * (2 * D) + 256 * h + 8 * dg); kr[i] = *(const GAS u32x4*)(QKC + (rn + 4 * tp + i) * (2 * D) + D + 256 * h + 8 * dg); }
            va = *(const GAS u32x4*)(VM + (rn + 2 * sp) * D + 256 * h + v0 + 8 * vg); vc = *(const GAS u32x4*)(VM + (rn + 2 * sp + 1) * D + 256 * h + v0 + 8 * vg);
 }
        LDS_BARRIER();
        for (int j = 0; j < ns_t; ++j) { const int idx = sidx0 + j, ti = idx >= 6 ? 3 : (idx >= 3 ? 2 : (idx >= 1 ? 1 : 0)), si = idx - ti * (ti + 1) / 2;
            f32x4 acc = (f32x4){0.f, 0.f, 0.f, 0.f};
            bf16x8 kfa[8], qfa[8];
#pragma unroll
            for (int kk = 0; kk < 8; ++kk) { kfa[kk] = *(const LAS bf16x8*)(KK + (16 * si + fr) * QS_LD + 32 * kk + 8 * fq); qfa[kk] = *(const LAS bf16x8*)(Qs + (16 * ti + fr) * QS_LD + 32 * kk + 8 * fq); }
            const int t = 16 * ti + fr; const float rt = ROWT[t];
            float ct[4];
#pragma unroll
            for (int r = 0; r < 4; ++r) ct[r] = COLT[16 * si + 4 * fq + r];
#pragma unroll
            for (int kk = 0; kk < 8; ++kk) acc = __builtin_amdgcn_mfma_f32_16x16x32_bf16(kfa[kk], qfa[kk], acc, 0, 0, 0);
            float sv[4];
#pragma unroll
            for (int r = 0; r < 4; ++r) { const int s = 16 * si + 4 * fq + r; sv[r] = (s <= t) ? __expf(rt + ct[r]) * acc[r] : 0.f; }
            u32x2 o; o.x = pk2(sv[0], sv[1]); o.y = pk2(sv[2], sv[3]);
            *(LAS u32x2*)(Ss + t * SLD + 16 * si + 4 * fq) = o; }
        f32x4 nacc[3];
        { const int ti = wid & 3, vb = wid >> 2;
#pragma unroll
          for (int j = 0; j < 3; ++j) nacc[j] = (f32x4){0.f, 0.f, 0.f, 0.f};
          bf16x8 qfa[8];
#pragma unroll
          for (int kk = 0; kk < 8; ++kk) qfa[kk] = *(const LAS bf16x8*)(Qs + (16 * ti + fr) * QS_LD + 32 * kk + 8 * fq);
#pragma unroll
          for (int j = 0; j < 3; ++j) if (j < nn_t) { bf16x8 cfa[8];
#pragma unroll
              for (int kk = 0; kk < 8; ++kk) cfa[kk] = *(const LAS bf16x8*)(Cs + (16 * (vb + 2 * j) + fr) * CS_LD + 32 * kk + 8 * fq);
#pragma unroll
              for (int kk = 0; kk < 8; ++kk) nacc[j] = __builtin_amdgcn_mfma_f32_16x16x32_bf16(cfa[kk], qfa[kk], nacc[j], 0, 0, 0); }
          const float wi = WINTER[16 * ti + fr];
#pragma unroll
          for (int j = 0; j < 3; ++j) nacc[j] = nacc[j] * wi; }
        LDS_BARRIER();
        { const float w0 = WIN[4 * tp], w1 = WIN[4 * tp + 1], w2 = WIN[4 * tp + 2], w3 = WIN[4 * tp + 3];
          const unsigned k0w[4] = {kc[0].x, kc[0].y, kc[0].z, kc[0].w}, k1w[4] = {kc[1].x, kc[1].y, kc[1].z, kc[1].w}, k2w[4] = {kc[2].x, kc[2].y, kc[2].z, kc[2].w}, k3w[4] = {kc[3].x, kc[3].y, kc[3].z, kc[3].w};
#pragma unroll
          for (int e = 0; e < 4; ++e) {
              u32x2 lo, hi; lo.x = pk2(w0 * bflo(k0w[e]), w1 * bflo(k1w[e])); lo.y = pk2(w2 * bflo(k2w[e]), w3 * bflo(k3w[e]));
              hi.x = pk2(w0 * bfhi(k0w[e]), w1 * bfhi(k1w[e])); hi.y = pk2(w2 * bfhi(k2w[e]), w3 * bfhi(k3w[e]));
              const int pc = ((((tp >> 1) + (dg >> 1)) & 7) << 3) + ((tp & 1) << 2);
              *(LAS u32x2*)(KK + (8 * dg + 2 * e) * SLD + pc) = lo; *(LAS u32x2*)(KK + (8 * dg + 2 * e + 1) * SLD + pc) = hi; } }
        bf16x8 sfa[2], vfa[3][2];
#pragma unroll
        for (int kk = 0; kk < 2; ++kk) { sfa[kk] = *(const LAS bf16x8*)(Ss + (16 * (wid & 3) + fr) * SLD + 32 * kk + 8 * fq);
#pragma unroll
            for (int j = 0; j < 3; ++j) vfa[j][kk] = *(const LAS bf16x8*)(VT + (16 * ((wid >> 2) + 2 * (j < nn_t ? j : 0)) + fr) * SLD + 32 * kk + 8 * fq); }
#pragma unroll
        for (int j = 0; j < 3; ++j) if (j < nn_t) { const int ti = wid & 3, vi = (wid >> 2) + 2 * j;
            f32x4 acc = nacc[j];
#pragma unroll
            for (int kk = 0; kk < 2; ++kk) acc = __builtin_amdgcn_mfma_f32_16x16x32_bf16(vfa[j][kk], sfa[kk], acc, 0, 0, 0);
            const int t = 16 * ti + fr;
            if (vi < 4) { u32x2 o; o.x = pk2(acc[0], acc[1]); o.y = pk2(acc[2], acc[3]); *(GAS u32x2*)(HM + (r0 + t) * D + 256 * h + v0 + 16 * vi + 4 * fq) = o; }
            else if (js == 0 && fq == 0) DEN[(r0 + t) * 4 + h] = fmaxf(fabsf(acc[0]), DFLOOR[t]); }
        LDS_BARRIER();
        { const float decay = MISC[0];
          bf16x8 ktf[2][2], vtf[2][5];
#pragma unroll
          for (int kk = 0; kk < 2; ++kk) {
#pragma unroll
              for (int di = 0; di < 2; ++di) ktf[kk][di] = *(const LAS bf16x8*)(KK + (dbase + 16 * di + fr) * SLD + (((4 * kk + fq + 2 * wid + di) & 7) << 3));
#pragma unroll
              for (int vi = 0; vi < 5; ++vi) vtf[kk][vi] = *(const LAS bf16x8*)(VT + (16 * vi + fr) * SLD + 32 * kk + 8 * fq); }
#pragma unroll
          for (int vi = 0; vi < 5; ++vi)
#pragma unroll
              for (int di = 0; di < 2; ++di) C[vi][di] = C[vi][di] * decay;
#pragma unroll
          for (int kk = 0; kk < 2; ++kk)
#pragma unroll
              for (int vi = 0; vi < 5; ++vi)
#pragma unroll
                  for (int di = 0; di < 2; ++di) C[vi][di] = __builtin_amdgcn_mfma_f32_16x16x32_bf16(ktf[kk][di], vtf[kk][vi], C[vi][di], 0, 0, 0);
          if (ch + 1 < NCH) {
#pragma unroll
              for (int vi = 0; vi < 5; ++vi)
#pragma unroll
                  for (int di = 0; di < 2; ++di) { u32x2 o; o.x = pk2(C[vi][di][0], C[vi][di][1]); o.y = pk2(C[vi][di][2], C[vi][di][3]);
                      *(LAS u32x2*)(Cs + (16 * vi + fr) * CS_LD + dbase + 16 * di + 4 * fq) = o; } }
          m_run = MISC[1]; }
        LDS_BARRIER();
    }
    { const int fr = lane & 15, fq = lane >> 4;
      float* Co = p.out + O_CP; float* no = p.out + O_NP; float* mo = p.out + O_MP;
#pragma unroll
      for (int vi = 0; vi < 4; ++vi)
#pragma unroll
          for (int di = 0; di < 2; ++di) *(GAS f32x4*)(Co + ((size_t)(b * 4 + h) * 256 + v0 + 16 * vi + fr) * 256 + dbase + 16 * di + 4 * fq) = C[vi][di];
      if (js == 0) {
          if (fr == 0) {
#pragma unroll
              for (int di = 0; di < 2; ++di) *(GAS f32x4*)(no + (size_t)(b * 4 + h) * 256 + dbase + 16 * di + 4 * fq) = C[4][di]; }
          if (tid == 0) mo[b * 4 + h] = m_run; } }
}

__device__ __forceinline__ void mlstm_sample_valu(const Params& p, int b, int h) {
    int tid = threadIdx.x; asm volatile("" : "+v"(tid));
    const int lane = tid & 63, wid = __builtin_amdgcn_readfirstlane(tid >> 6);
    unsigned char* ws = p.ws; asm volatile("" : "+s"(ws));
    const GAS bf16_t* QKC = (const GAS bf16_t*)(ws + WS_QKC); const GAS bf16_t* VM = (const GAS bf16_t*)(ws + WS_Z + 4 * RSZ);
    const GAS float* G = (const GAS float*)(ws + WS_G); GAS float* DEN = (GAS float*)(ws + WS_DEN); GAS bf16_t* HM = (GAS bf16_t*)(ws + WS_HM);
    const size_t r0 = (size_t)NP + (size_t)b * TS;
    const GAS float* C0 = (const GAS float*)p.state_C + (size_t)(b * 4 + h) * 65536; GAS float* Co = (GAS float*)p.out + O_CS + (size_t)(b * 4 + h) * 65536;
    const int vbase = wid * 32;
    f32x4 cpre[8];
#pragma unroll
    for (int i = 0; i < 8; ++i) cpre[i] = __builtin_nontemporal_load((const GAS f32x4*)(C0 + (size_t)(vbase + i) * 256 + 4 * lane));
    float q[4][4], k[4][4], vreg[4], ic[4], fc[4];
#pragma unroll
    for (int t = 0; t < 4; ++t) { const u32x2 wq = *(const GAS u32x2*)(QKC + (r0 + t) * (2 * D) + 256 * h + 4 * lane), wk = *(const GAS u32x2*)(QKC + (r0 + t) * (2 * D) + D + 256 * h + 4 * lane);
        q[t][0] = bflo(wq.x); q[t][1] = bfhi(wq.x); q[t][2] = bflo(wq.y); q[t][3] = bfhi(wq.y); k[t][0] = bflo(wk.x); k[t][1] = bfhi(wk.x); k[t][2] = bflo(wk.y); k[t][3] = bfhi(wk.y);
        const bf16_t vv = VM[(r0 + t) * D + 256 * h + vbase + (lane & 31)]; vreg[t] = __uint_as_float((unsigned)vv << 16);
        ic[t] = G[(r0 + t) * 8 + h]; fc[t] = G[(r0 + t) * 8 + 4 + h]; }
    const float m0 = p.state_m[b * 4 + h];
    float bc[4], a[4], pm[4], mt[4], winter[4], win[4];
    bc[0] = fc[0]; bc[1] = bc[0] + fc[1]; bc[2] = bc[1] + fc[2]; bc[3] = bc[2] + fc[3];
#pragma unroll
    for (int t = 0; t < 4; ++t) a[t] = ic[t] - bc[t];
    pm[0] = a[0]; pm[1] = fmaxf(pm[0], a[1]); pm[2] = fmaxf(pm[1], a[2]); pm[3] = fmaxf(pm[2], a[3]);
#pragma unroll
    for (int t = 0; t < 4; ++t) { const float inter = bc[t] + m0; mt[t] = fmaxf(inter, bc[t] + pm[t]); winter[t] = __expf(inter - mt[t]); }
    const float blast = bc[3], mnew = fmaxf(blast + m0, blast + pm[3]), decay = __expf(blast + m0 - mnew);
#pragma unroll
    for (int s = 0; s < 4; ++s) win[s] = __expf(blast + a[s] - mnew);
    const int tl = lane >> 4;
    float wt = winter[0], rtl = bc[0] - mt[0], St[4];
#pragma unroll
    for (int t = 1; t < 4; ++t) if (tl == t) { wt = winter[t]; rtl = bc[t] - mt[t]; }
#pragma unroll
    for (int s = 0; s < 4; ++s) { float d0 = 0.f, d1 = 0.f, d2 = 0.f, d3 = 0.f;
#pragma unroll
        for (int e = 0; e < 4; ++e) { d0 += q[0][e] * k[s][e]; d1 += q[1][e] * k[s][e]; d2 += q[2][e] * k[s][e]; d3 += q[3][e] * k[s][e]; }
        d0 = wave_sum(d0); d1 = wave_sum(d1); d2 = wave_sum(d2); d3 = wave_sum(d3);
        const float dd = tl == 0 ? d0 : (tl == 1 ? d1 : (tl == 2 ? d2 : d3));
        St[s] = (s <= tl) ? __expf(rtl + a[s]) * dd : 0.f; }
#define RED4(p0, p1, p2, p3, out) do { const bool _hi = lane >= 32; \
        const float _s0 = (_hi ? p2 : p0) + __shfl_xor(_hi ? p0 : p2, 32), _s1 = (_hi ? p3 : p1) + __shfl_xor(_hi ? p1 : p3, 32); \
        const bool _h2 = (lane & 16) != 0; float _u = (_h2 ? _s1 : _s0) + __shfl_xor(_h2 ? _s0 : _s1, 16); \
        _u += __shfl_xor(_u, 8); _u += __shfl_xor(_u, 4); _u += __shfl_xor(_u, 2); _u += __shfl_xor(_u, 1); out = _u; } while (0)
    float R0 = 0.f, R1 = 0.f;
    for (int i0 = 0; i0 < 32; i0 += 8) {
        f32x4 c[8];
#pragma unroll
        for (int i = 0; i < 8; ++i) c[i] = cpre[i];
        if (i0 + 8 < 32) {
#pragma unroll
            for (int i = 0; i < 8; ++i) cpre[i] = __builtin_nontemporal_load((const GAS f32x4*)(C0 + (size_t)(vbase + i0 + 8 + i) * 256 + 4 * lane)); }
#pragma unroll
        for (int i = 0; i < 8; ++i) { const int row = i0 + i;
            float vs[4];
#pragma unroll
            for (int s = 0; s < 4; ++s) vs[s] = __shfl(vreg[s], row);
            float p0 = 0.f, p1 = 0.f, p2 = 0.f, p3 = 0.f; f32x4 cn;
#pragma unroll
            for (int e = 0; e < 4; ++e) { p0 += c[i][e] * q[0][e]; p1 += c[i][e] * q[1][e]; p2 += c[i][e] * q[2][e]; p3 += c[i][e] * q[3][e];
                cn[e] = decay * c[i][e] + ((win[0] * vs[0]) * k[0][e] + (win[1] * vs[1]) * k[1][e]) + ((win[2] * vs[2]) * k[2][e] + (win[3] * vs[3]) * k[3][e]); }
            __builtin_nontemporal_store(cn, (GAS f32x4*)(Co + (size_t)(vbase + row) * 256 + 4 * lane));
            float tot; RED4(p0, p1, p2, p3, tot);
            const float nv = wt * tot + ((St[0] * vs[0] + St[1] * vs[1]) + (St[2] * vs[2] + St[3] * vs[3]));
            if ((lane & 15) == (row & 15)) { if (row < 16) R0 = nv; else R1 = nv; } }
    }
    { const int j = lane & 15;
      GAS bf16_t* hp = HM + (r0 + tl) * D + 256 * h + vbase + j;
      hp[0] = (bf16_t)(pk2(R0, 0.f) & 0xffffu); hp[16] = (bf16_t)(pk2(R1, 0.f) & 0xffffu); }
    if (wid == 0) {
        const f32x4 nrow = *(const GAS f32x4*)(p.state_n + (size_t)(b * 4 + h) * 256 + 4 * lane);
        float p0 = 0.f, p1 = 0.f, p2 = 0.f, p3 = 0.f; f32x4 nn;
#pragma unroll
        for (int e = 0; e < 4; ++e) { p0 += nrow[e] * q[0][e]; p1 += nrow[e] * q[1][e]; p2 += nrow[e] * q[2][e]; p3 += nrow[e] * q[3][e];
            nn[e] = decay * nrow[e] + (win[0] * k[0][e] + win[1] * k[1][e]) + (win[2] * k[2][e] + win[3] * k[3][e]); }
        *(GAS f32x4*)(p.out + O_NS + (size_t)(b * 4 + h) * 256 + 4 * lane) = nn;
        float tot; RED4(p0, p1, p2, p3, tot);
        const float den = wt * tot + ((St[0] + St[1]) + (St[2] + St[3]));
        float mtl = mt[0];
#pragma unroll
        for (int t = 1; t < 4; ++t) if (tl == t) mtl = mt[t];
        if ((lane & 15) == 0) DEN[(r0 + tl) * 4 + h] = fmaxf(fabsf(den), __expf(-mtl));
        if (lane == 0) p.out[O_MS + b * 4 + h] = mnew;
    }
#undef RED4
}

__device__ __forceinline__ void gmlp_prompt_item(const Params& p, LAS unsigned char* lds, int item) {
    int tid = threadIdx.x; asm volatile("" : "+v"(tid));
    const int lane = tid & 63, wid = __builtin_amdgcn_readfirstlane(tid >> 6), fr = lane & 15, fq = lane >> 4;
    unsigned char* ws = p.ws; asm volatile("" : "+s"(ws));
    const bf16_t* U = (const bf16_t*)(ws + WS_Z); const bf16_t* GV = (const bf16_t*)(ws + WS_Z + RSZ); bf16_t* AOUT = (bf16_t*)(ws + WS_AOUT);
    const bf16_t* WSB = (const bf16_t*)(ws + WS_WSB);
    const size_t r0 = (size_t)item * 128;
    constexpr int VLD = 136;
    LAS bf16_t* VT = (LAS bf16_t*)lds;
    LAS float* MEAN = (LAS float*)(lds + 69632); LAS float* RSTD = MEAN + 128;
    __syncthreads();
#pragma unroll
    for (int grp = 0; grp < 4; ++grp) { const int row = wid * 16 + grp * 4 + fq; float s = 0.f, ss = 0.f;
#pragma unroll
        for (int i = 0; i < 8; ++i) { const u32x4 w = *(const GAS u32x4*)(GV + (r0 + row) * D + (i * 16 + fr) * 8);
            const unsigned ww[4] = {w.x, w.y, w.z, w.w};
#pragma unroll
            for (int e = 0; e < 4; ++e) { const f32x2 gg = gelu_pk((f32x2){bflo(ww[e]), bfhi(ww[e])}); const float a = gg.x, c = gg.y; s += a + c; ss += a * a + c * c; } }
#pragma unroll
        for (int o = 1; o < 16; o <<= 1) { s += __shfl_xor(s, o); ss += __shfl_xor(ss, o); }
        if (fr == 0) { const float mu = s * (1.0f / D); MEAN[row] = mu; RSTD[row] = rsqrtf(fmaxf(ss * (1.0f / D) - mu * mu, 0.f) + EPS); } }
    __syncthreads();
    const int nks = (16 * wid + 15) / 32 + 1;
    for (int g = 0; g < 4; ++g) {
        { const int s = 2 * lane; const int cb = 256 * g + 32 * wid;
          const float mu0 = MEAN[s], rs0 = RSTD[s], mu1 = MEAN[s + 1], rs1 = RSTD[s + 1];
#pragma unroll
          for (int i = 0; i < 4; ++i) { const u32x4 a = *(const GAS u32x4*)(GV + (r0 + s) * D + cb + 8 * i), c = *(const GAS u32x4*)(GV + (r0 + s + 1) * D + cb + 8 * i);
              const unsigned aw[4] = {a.x, a.y, a.z, a.w}, cw[4] = {c.x, c.y, c.z, c.w};
#pragma unroll
              for (int e = 0; e < 4; ++e) { const int c0 = cb + 8 * i + 2 * e; const float g0 = p.ln_g[c0], g1 = p.ln_g[c0 + 1], b0 = p.ln_b[c0], b1 = p.ln_b[c0 + 1];
                  const f32x2 ya = gelu_pk((f32x2){bflo(aw[e]), bfhi(aw[e])}), yc = gelu_pk((f32x2){bflo(cw[e]), bfhi(cw[e])});
                  const float x00 = (ya.x - mu0) * rs0 * g0 + b0, x01 = (ya.y - mu0) * rs0 * g1 + b1;
                  const float x10 = (yc.x - mu1) * rs1 * g0 + b0, x11 = (yc.y - mu1) * rs1 * g1 + b1;
                  *(LAS unsigned*)(VT + (32 * wid + 8 * i + 2 * e) * VLD + s) = pk2(x00, x10);
                  *(LAS unsigned*)(VT + (32 * wid + 8 * i + 2 * e + 1) * VLD + s) = pk2(x01, x11); } } }
        bf16x8 af[4];
#pragma unroll
        for (int ks = 0; ks < 4; ++ks) af[ks] = (ks < nks) ? *(const GAS bf16x8*)(WSB + ((size_t)(g * 128 + 16 * wid + fr)) * 128 + 32 * ks + 8 * fq) : (bf16x8){0, 0, 0, 0, 0, 0, 0, 0};
        const int t = 16 * wid + fr; const float bs = p.b_s[g * 128 + t];
        u32x2 uu16[16];
#pragma unroll
        for (int ci = 0; ci < 16; ++ci) uu16[ci] = *(const GAS u32x2*)(U + (r0 + t) * D + 256 * g + 16 * ci + 4 * fq);
        __syncthreads();
#pragma unroll
        for (int ci = 0; ci < 16; ++ci) {
            f32x4 acc = (f32x4){0.f, 0.f, 0.f, 0.f};
#pragma unroll
            for (int ks = 0; ks < 4; ++ks) if (ks < nks) { const bf16x8 vf = *(const LAS bf16x8*)(VT + (16 * ci + fr) * VLD + 32 * ks + 8 * fq);
                acc = __builtin_amdgcn_mfma_f32_16x16x32_bf16(vf, af[ks], acc, 0, 0, 0); }
            const size_t off = (r0 + t) * D + 256 * g + 16 * ci + 4 * fq;
            const u32x2 uu = uu16[ci];
            const f32x2 ga = gelu_pk((f32x2){bflo(uu.x), bfhi(uu.x)}), gb = gelu_pk((f32x2){bflo(uu.y), bfhi(uu.y)});
            u32x2 o; o.x = pk2(ga.x * (acc[0] + bs), ga.y * (acc[1] + bs)); o.y = pk2(gb.x * (acc[2] + bs), gb.y * (acc[3] + bs));
            *(GAS u32x2*)(AOUT + off) = o; }
        __syncthreads();
    }
}

__device__ __forceinline__ void gmlp_sample_item(const Params& p, LAS unsigned char* lds, int b) {
    int tid = threadIdx.x; asm volatile("" : "+v"(tid));
    const int lane = tid & 63, wid = tid >> 6;
    unsigned char* ws = p.ws;
    const bf16_t* U = (const bf16_t*)(ws + WS_Z); const bf16_t* GV = (const bf16_t*)(ws + WS_Z + RSZ); bf16_t* AOUT = (bf16_t*)(ws + WS_AOUT);
    const size_t r0 = (size_t)NP + (size_t)b * TS;
    LAS float* ST = (LAS float*)lds;
    __syncthreads();
    if (wid < 4) { float s = 0.f, ss = 0.f;
#pragma unroll
        for (int i = 0; i < 2; ++i) { const u32x4 w = *(const GAS u32x4*)(GV + (r0 + wid) * D + (i * 64 + lane) * 8); const unsigned ww[4] = {w.x, w.y, w.z, w.w};
#pragma unroll
            for (int e = 0; e < 4; ++e) { const f32x2 gg = gelu_pk((f32x2){bflo(ww[e]), bfhi(ww[e])}); const float a = gg.x, c = gg.y; s += a + c; ss += a * a + c * c; } }
        s = wave_sum(s); ss = wave_sum(ss);
        if (lane == 0) { const float mu = s * (1.0f / D); ST[wid] = mu; ST[4 + wid] = rsqrtf(fmaxf(ss * (1.0f / D) - mu * mu, 0.f) + EPS); } }
    __syncthreads();
    const int c0 = 2 * tid, g = c0 >> 8;
    float vn[4][2];
    const float lg0 = p.ln_g[c0], lg1 = p.ln_g[c0 + 1], lb0 = p.ln_b[c0], lb1 = p.ln_b[c0 + 1];
#pragma unroll
    for (int s = 0; s < 4; ++s) { const unsigned w = *(const GAS unsigned*)(GV + (r0 + s) * D + c0); const float mu = ST[s], rs = ST[4 + s];
        const f32x2 gy = gelu_pk((f32x2){bflo(w), bfhi(w)});
        vn[s][0] = (gy.x - mu) * rs * lg0 + lb0; vn[s][1] = (gy.y - mu) * rs * lg1 + lb1;
        *(GAS f32x2*)(p.out + O_GMV + ((size_t)b * TS + s) * D + c0) = (f32x2){vn[s][0], vn[s][1]}; }
#pragma unroll
    for (int t = 0; t < 4; ++t) { float s0 = p.b_s[g * 128 + t], s1 = s0;
#pragma unroll
        for (int s = 0; s < 4; ++s) if (s <= t) { const float w = p.w_s[(size_t)(g * 128 + t) * 128 + s]; s0 += w * vn[s][0]; s1 += w * vn[s][1]; }
        const unsigned uu = *(const GAS unsigned*)(U + (r0 + t) * D + c0);
        const f32x2 gu = gelu_pk((f32x2){bflo(uu), bfhi(uu)});
        *(GAS unsigned*)(AOUT + (r0 + t) * D + c0) = pk2(gu.x * s0, gu.y * s1); }
}

__device__ __forceinline__ void conv_state_item(const Params& p, int seq) {
    const bf16_t* QK = (const bf16_t*)(p.ws + WS_Z + 2 * RSZ);
    const bool sample = seq >= NB_P; const int b = sample ? seq - NB_P : seq;
    const size_t rsrc = sample ? (size_t)NP + (size_t)b * TS + 1 : (size_t)b * SEQ + (SEQ - 3);
    float* dst = p.out + (sample ? O_CONVS : O_CONVP) + (size_t)b * 3 * 2 * D;
    int tid = threadIdx.x; asm volatile("" : "+v"(tid));
    for (int i = tid; i < 3 * 2 * D / 2; i += NT) { const unsigned w = ((const unsigned*)(QK + rsrc * 2 * D))[i]; *(GAS f32x2*)(dst + 2 * i) = (f32x2){bflo(w), bfhi(w)}; }
}

constexpr int LW_P = 16 * 32, LW_F1 = 16 * 176, LW_F2 = 44 * 32, LW_ALL = 3 * LW_P + LW_F1 + LW_F2, LW_ITEMS = LW_ALL / 8;
__device__ __forceinline__ void late_weight_item(const Params& p, LAS unsigned char* lds, int item) {
    int tid = threadIdx.x; asm volatile("" : "+v"(tid));
    const int lane = tid & 63, wid = tid >> 6;
    unsigned char* ws = p.ws; asm volatile("" : "+s"(ws));
    LAS float* scr = (LAS float*)(lds + wid * 8448);
    __syncthreads();
    int r = item * 8 + wid;
    if (r < LW_P) { transpose_item(p.w_proj_a, D, D, (bf16_t*)(ws + WS_WPA), (r / 32) * 64, (r % 32) * 32, (r % 32) * 32, scr, lane); return; } r -= LW_P;
    if (r < LW_P) { transpose_item(p.w_proj_b, D, D, (bf16_t*)(ws + WS_WPB), (r / 32) * 64, (r % 32) * 32, (r % 32) * 32, scr, lane); return; } r -= LW_P;
    if (r < LW_P) { transpose_item(p.w_out, D, D, (bf16_t*)(ws + WS_WO), (r / 32) * 64, (r % 32) * 32, (r % 32) * 32, scr, lane); return; } r -= LW_P;
    if (r < LW_F1) { const int kb = r / 176, nb = r % 176, n0 = nb * 32, pn = n0 >> 8, within = n0 & 255, half = within >> 7, jj0 = within & 127;
        transpose_item(p.w_ffn_in, 2 * DFF, D, (bf16_t*)(ws + WS_WF1), kb * 64, half * DFF + 128 * pn + jj0, n0, scr, lane); return; } r -= LW_F1;
    transpose_item(p.w_ffn_out, D, DFF, (bf16_t*)(ws + WS_WF2), (r / 32) * 64, (r % 32) * 32, (r % 32) * 32, scr, lane);
}

__device__ __forceinline__ void phase_bout(const Params& p) {
    int tid = threadIdx.x; asm volatile("" : "+v"(tid));
    const int lane = tid & 63, wid = tid >> 6, gw = blockIdx.x * NWAVES + wid, NGW = gridDim.x * NWAVES;
    const GAS bf16_t* HM = (const GAS bf16_t*)(p.ws + WS_HM); const GAS bf16_t* SO = (const GAS bf16_t*)(p.ws + WS_Z + 5 * RSZ); const GAS float* DEN = (const GAS float*)(p.ws + WS_DEN);
    GAS bf16_t* BOUT = (GAS bf16_t*)(p.ws + WS_BOUT);
    f32x4 g4[4];
#pragma unroll
    for (int hh = 0; hh < 4; ++hh) g4[hh] = *(const GAS f32x4*)(p.hn_g + 256 * hh + 4 * lane);
    for (int row0 = gw; row0 < MT; row0 += 2 * NGW) {
        u32x2 w[2][4], so[2][4]; f32x4 dn[2];
#pragma unroll
        for (int rr = 0; rr < 2; ++rr) { const int row = (row0 + rr * NGW < MT) ? row0 + rr * NGW : row0;
            dn[rr] = *(const GAS f32x4*)(DEN + (size_t)row * 4);
#pragma unroll
            for (int hh = 0; hh < 4; ++hh) { const size_t off = (size_t)row * D + 256 * hh + 4 * lane; w[rr][hh] = *(const GAS u32x2*)(HM + off); so[rr][hh] = *(const GAS u32x2*)(SO + off); } }
#pragma unroll
        for (int rr = 0; rr < 2; ++rr) { const int row = row0 + rr * NGW; if (row < MT) {
#pragma unroll
            for (int hh = 0; hh < 4; ++hh) {
                const size_t off = (size_t)row * D + 256 * hh + 4 * lane; const float inv = 1.0f / dn[rr][hh];
                float x[4] = {bflo(w[rr][hh].x) * inv, bfhi(w[rr][hh].x) * inv, bflo(w[rr][hh].y) * inv, bfhi(w[rr][hh].y) * inv};
                const float mu = wave_sum((x[0] + x[1]) + (x[2] + x[3])) * (1.0f / 256.f);
                float q = 0.f;
#pragma unroll
                for (int e = 0; e < 4; ++e) { x[e] -= mu; q += x[e] * x[e]; }
                const float rs = rsqrtf(wave_sum(q) * (1.0f / 256.f) + EPS);
                u32x2 o; o.x = pk2(sigmoid_f(bflo(so[rr][hh].x)) * x[0] * rs * g4[hh][0], sigmoid_f(bfhi(so[rr][hh].x)) * x[1] * rs * g4[hh][1]); o.y = pk2(sigmoid_f(bflo(so[rr][hh].y)) * x[2] * rs * g4[hh][2], sigmoid_f(bfhi(so[rr][hh].y)) * x[3] * rs * g4[hh][3]);
                *(GAS u32x2*)(BOUT + off) = o; } } }
    }
}
template <bool TO_BF16>
__device__ __forceinline__ void phase_rms(const Params& p, const float* gain, bf16_t* dst, int rbeg = 0) {
    int tid = threadIdx.x; asm volatile("" : "+v"(tid));
    const int lane = tid & 63, wid = tid >> 6, gw = blockIdx.x * NWAVES + wid, NGW = gridDim.x * NWAVES;
    const GAS bf16_t* XB = (const GAS bf16_t*)(p.ws + WS_BOUT); GAS float* Y = (GAS float*)p.out + O_Y;
    f32x4 g4[4];
#pragma unroll
    for (int j = 0; j < 4; ++j) g4[j] = ((const GAS f32x4*)gain)[lane + 64 * j];
    for (int row0 = rbeg + gw; row0 < MT; row0 += 4 * NGW) {
        u32x2 v[4][4];
#pragma unroll
        for (int rr = 0; rr < 4; ++rr) { const int row = (row0 + rr * NGW < MT) ? row0 + rr * NGW : row0;
#pragma unroll
            for (int j = 0; j < 4; ++j) v[rr][j] = ((const GAS u32x2*)(XB + (size_t)row * D))[lane + 64 * j]; }
#pragma unroll
        for (int rr = 0; rr < 4; ++rr) { const int row = row0 + rr * NGW; if (row < MT) {
            f32x4 x[4]; float ss = 0.f;
#pragma unroll
            for (int j = 0; j < 4; ++j) { x[j] = (f32x4){bflo(v[rr][j].x), bfhi(v[rr][j].x), bflo(v[rr][j].y), bfhi(v[rr][j].y)}; ss += (x[j][0] * x[j][0] + x[j][1] * x[j][1]) + (x[j][2] * x[j][2] + x[j][3] * x[j][3]); }
            const float r = rsqrtf(wave_sum(ss) * (1.0f / D) + EPS);
#pragma unroll
            for (int j = 0; j < 4; ++j) { const f32x4 o4 = x[j] * r * g4[j];
                if (TO_BF16) { u32x2 o; o.x = pk2(o4[0], o4[1]); o.y = pk2(o4[2], o4[3]); ((GAS u32x2*)((GAS bf16_t*)dst + (size_t)row * D))[lane + 64 * j] = o; }
                else ((GAS f32x4*)(Y + (size_t)row * D))[lane + 64 * j] = o4; } } }
    }
}

#ifndef PHMASK
#define PHMASK 0xFFFF
#endif
__global__ void __launch_bounds__(NT) fwd_megakernel(Params p) {
    extern __shared__ __attribute__((aligned(16))) unsigned char lds_raw[];
    LAS unsigned char* lds = (LAS unsigned char*)lds_raw;
    unsigned char* ws = p.ws;
    const int G = gridDim.x, bid = blockIdx.x;
    const int tid = threadIdx.x, lane = tid & 63, wid = __builtin_amdgcn_readfirstlane(tid >> 6), fr = lane & 15, fq = lane >> 4;
    volatile LAS unsigned* xst = (volatile LAS unsigned*)(lds + LDS_BYTES - 32);
    if (tid == 0) { xst[0] = 0u; xst[1] = 0u; }
    __syncthreads();
    const XcdBarrier bar = xcd_barrier_post((unsigned*)(ws + WS_CTL), xst);
#define GRID_BAR() xcd_barrier(bar)

#if PHMASK & 1
    phase0(p, lds);
#endif
    GRID_BAR();
#if PHMASK & 2
    { pg8::Gemm g{(const bf16_t*)(ws + WS_H), (const bf16_t*)(ws + WS_WZ), MT, NZ, D}; pg8::StaticOrder S; S.init(MT, NZ, G, bid);
      EpiZ E{(bf16_t*)(ws + WS_Z), p.b_gate}; pg8::gemm_phase(lds, g, S, E); }
    { constexpr int NU = (MT / 256) * (NZ / 256); const int extra = NU % G;
      if (bid >= extra) for (int it = bid - extra; it < LW_ITEMS; it += G - extra) late_weight_item(p, lds, it); }
#endif
    GRID_BAR();
#if PHMASK & 1024
    phase_conv(p);
    phase_gate_scan(p);
    for (int it = bid; it < NB_P + NB_S; it += G) conv_state_item(p, it);
#endif
    GRID_BAR();
#if PHMASK & 4
#ifndef REP2
#define REP2 1
#endif
    for (int rep = 0; rep < REP2; ++rep) {
      for (int it = bid; it < 128; it += G) { const int xcd = it & 7, k = it >> 3, bh = xcd * 4 + (k >> 2);
          mlstm_prompt_item(p, lds, bh >> 2, bh & 3, k & 3); }
      unsigned* qctr = (unsigned*)(ws + WS_CTL) + 16 * rep;
      LAS int* qslot = (LAS int*)(lds + LDS_BYTES - 16);
      constexpr int N_A = 128, N_B = 512, N_C = 128, N_ALL = N_A + N_B + N_C;
      int nxt = 0;
      if (threadIdx.x == 0) nxt = (int)atomicAdd(qctr, 1u);
      for (;;) {
          __syncthreads();
          if (threadIdx.x == 0) *qslot = nxt;
          __syncthreads();
          int it = *qslot;
          if (it >= N_ALL) break;
          if (threadIdx.x == 0) nxt = (int)atomicAdd(qctr, 1u);
          if (it < N_A) { gmlp_prompt_item(p, lds, it); continue; }
          it -= N_A;
          if (it < N_B) { mlstm_sample_valu(p, it >> 2, it & 3); continue; }
          it -= N_B;
          gmlp_sample_item(p, lds, it);
      } }
#endif
    GRID_BAR();
#if PHMASK & 8
    { pg8::StaticOrder S; S.init(NP, D, G, bid);
      pg8::Gemm g{(const bf16_t*)(ws + WS_AOUT), (const bf16_t*)(ws + WS_WPA), NP, D, D}; EpiT1 E{(bf16_t*)(ws + WS_Z), (const bf16_t*)(ws + WS_Z + 6 * RSZ)};
      if (bid & 1) { pg8::gemm_phase(lds, g, S, E); phase_bout(p); }
      else { phase_bout(p); pg8::gemm_phase(lds, g, S, E); } }
#endif
    GRID_BAR();
#if PHMASK & 16
    { pg8::StaticOrder S; S.init(NP, D, G, bid);
      { pg8::Gemm g{(const bf16_t*)(ws + WS_BOUT), (const bf16_t*)(ws + WS_WPB), NP, D, D}; EpiT2 E{(const bf16_t*)(ws + WS_Z), (const bf16_t*)(ws + WS_Z + 7 * RSZ), (bf16_t*)(ws + WS_H)}; pg8::gemm_phase(lds, g, S, E); }
      for (int tl = bid; tl < 256; tl += G) { const int r0 = NP + (tl >> 5) * 64, c0 = (tl & 31) * 32;
          f32x4 acc[4][2]; ZERO_ACC42(acc);
          small_tile_mma<D>((const bf16_t*)(ws + WS_AOUT), (const bf16_t*)(ws + WS_WPA), r0, c0, wid, fr, fq, acc);
          const f32x4 pa = small_tile_reduce(lds, acc, wid, fr, fq);
          ZERO_ACC42(acc);
          small_tile_mma<D>((const bf16_t*)(ws + WS_BOUT), (const bf16_t*)(ws + WS_WPB), r0, c0, wid, fr, fq, acc);
          const f32x4 pb = small_tile_reduce(lds, acc, wid, fr, fq);
          const size_t off = (size_t)(r0 + (tid >> 3)) * D + c0 + 4 * (tid & 7);
          const u32x2 ga = *(const GAS u32x2*)((const bf16_t*)(ws + WS_Z + 6 * RSZ) + off), gb = *(const GAS u32x2*)((const bf16_t*)(ws + WS_Z + 7 * RSZ) + off);
          u32x2 o; o.x = pk2(bflo(ga.x) * pa[0] + bflo(gb.x) * pb[0], bfhi(ga.x) * pa[1] + bfhi(gb.x) * pb[1]);
          o.y = pk2(bflo(ga.y) * pa[2] + bflo(gb.y) * pb[2], bfhi(ga.y) * pa[3] + bfhi(gb.y) * pb[3]);
          *(GAS u32x2*)((bf16_t*)(ws + WS_H) + off) = o; } }
#endif
    GRID_BAR();
#if PHMASK & 32
    { pg8::Gemm g{(const bf16_t*)(ws + WS_H), (const bf16_t*)(ws + WS_WO), NP, D, D}; pg8::StaticOrder S; S.init(NP, D, G, bid);
      if (G == (NP / 256) * (D / 256)) { EpiNorm<true> E{p.x_prompt, (bf16_t*)(ws + WS_BOUT), (bf16_t*)(ws + WS_AOUT), nullptr, p.g_norm2, (float*)(ws + WS_XS), (unsigned*)(ws + WS_PCNT), (unsigned*)(ws + WS_CTL) + 60, 32u}; pg8::gemm_phase(lds, g, S, E); }
      else { EpiRes<true> E{p.x_prompt, (bf16_t*)(ws + WS_BOUT)}; pg8::gemm_phase(lds, g, S, E); }
      for (int tl = bid; tl < 256; tl += G) { const int r0 = NP + (tl >> 5) * 64, c0 = (tl & 31) * 32;
          f32x4 acc[4][2]; ZERO_ACC42(acc);
          small_tile_mma<D>((const bf16_t*)(ws + WS_H), (const bf16_t*)(ws + WS_WO), r0, c0, wid, fr, fq, acc);
          const f32x4 pa = small_tile_reduce(lds, acc, wid, fr, fq);
          const int row = r0 + (tid >> 3), col = c0 + 4 * (tid & 7);
          const f32x4 o = *(const GAS f32x4*)(p.x_sample + (size_t)(row - NP) * D + col) + pa;
          u32x2 w; w.x = pk2(o[0], o[1]); w.y = pk2(o[2], o[3]); *(GAS u32x2*)((bf16_t*)(ws + WS_BOUT) + (size_t)row * D + col) = w; } }
#endif
    GRID_BAR();
#if PHMASK & 64
    phase_rms<true>(p, p.g_norm2, (bf16_t*)(ws + WS_AOUT), G == (NP / 256) * (D / 256) ? NP : 0);
#endif
    GRID_BAR();
#if PHMASK & 128
    { pg8::Gemm g{(const bf16_t*)(ws + WS_AOUT), (const bf16_t*)(ws + WS_WF1), MT, 2 * DFF, D}; pg8::StaticOrder S; S.init(MT, 2 * DFF, G, bid);
      EpiFfn E{(bf16_t*)(ws + WS_Z)}; pg8::gemm_phase(lds, g, S, E); }
#endif
    GRID_BAR();
#if PHMASK & 256
    { pg8::Gemm g{(const bf16_t*)(ws + WS_Z), (const bf16_t*)(ws + WS_WF2), NP, D, DFF}; pg8::StaticOrder S; S.init(NP, D, G, bid);
      if (G == (NP / 256) * (D / 256)) { EpiNorm<false> E{nullptr, (bf16_t*)(ws + WS_BOUT), nullptr, p.out + O_Y, p.g_final, (float*)(ws + WS_XS), (unsigned*)(ws + WS_PCNT), (unsigned*)(ws + WS_CTL) + 60, 64u}; pg8::gemm_phase(lds, g, S, E); }
      else { EpiRes<false> E{nullptr, (bf16_t*)(ws + WS_BOUT)}; pg8::gemm_phase(lds, g, S, E); }
      for (int tl = bid; tl < 256; tl += G) { const int r0 = NP + (tl >> 5) * 64, c0 = (tl & 31) * 32;
          f32x4 acc[4][2]; ZERO_ACC42(acc);
          small_tile_mma<DFF>((const bf16_t*)(ws + WS_Z), (const bf16_t*)(ws + WS_WF2), r0, c0, wid, fr, fq, acc);
          const f32x4 pa = small_tile_reduce(lds, acc, wid, fr, fq);
          GAS u32x2* xp2 = (GAS u32x2*)((bf16_t*)(ws + WS_BOUT) + (size_t)(r0 + (tid >> 3)) * D + c0 + 4 * (tid & 7));
          const u32x2 t = *xp2; u32x2 w; w.x = pk2(bflo(t.x) + pa[0], bfhi(t.x) + pa[1]); w.y = pk2(bflo(t.y) + pa[2], bfhi(t.y) + pa[3]); *xp2 = w; } }
#endif
    GRID_BAR();
#if PHMASK & 512
    phase_rms<false>(p, p.g_final, nullptr, G == (NP / 256) * (D / 256) ? NP : 0);
#endif
}

extern "C" void kernel_launch(void* const* d_in, const int* in_sizes, int n_in, void* d_out, int out_size, void* d_ws, size_t ws_size, hipStream_t stream) {
    static int grid_blocks = 0;
    if (grid_blocks == 0) {
        if (n_in != 25 || ws_size < WS_END) { fprintf(stderr, "kernel_launch: unexpected inputs (%d) or workspace (%zu < %zu)\n", n_in, ws_size, (size_t)WS_END); grid_blocks = -1; return; }
        int dev = 0, cus = 0, per_cu = 0;
        hipGetDevice(&dev);
        hipDeviceGetAttribute(&cus, hipDeviceAttributeMultiprocessorCount, dev);
        if (hipFuncSetAttribute((const void*)fwd_megakernel, hipFuncAttributeMaxDynamicSharedMemorySize, LDS_BYTES) != hipSuccess) { fprintf(stderr, "kernel_launch: hipFuncSetAttribute failed\n"); grid_blocks = -1; return; }
        if (hipOccupancyMaxActiveBlocksPerMultiprocessor(&per_cu, (const void*)fwd_megakernel, NT, LDS_BYTES) != hipSuccess || per_cu < 1) { fprintf(stderr, "kernel_launch: occupancy query failed (%d)\n", per_cu); (void)hipGetLastError(); per_cu = 1; }
        grid_blocks = cus * per_cu;
        if (grid_blocks > 256) grid_blocks = 256;
    }
    if (grid_blocks < 0) return;
    (void)hipMemsetAsync((char*)d_ws + WS_CTL, 0, 32768, stream);
    Params p{};
    const float* const* in = (const float* const*)d_in;
    p.x_prompt = in[0]; p.x_sample = in[1]; p.state_conv = in[2]; p.state_C = in[3]; p.state_n = in[4]; p.state_m = in[5];
    p.g_norm1 = in[6]; p.w_in = in[7]; p.b_i = in[8]; p.b_f = in[9]; p.ln_g = in[10]; p.ln_b = in[11]; p.w_s = in[12]; p.b_s = in[13];
    p.conv_w = in[14]; p.conv_b = in[15]; p.hn_g = in[16]; p.b_gate = in[17]; p.w_proj_a = in[18]; p.w_proj_b = in[19]; p.w_out = in[20];
    p.g_norm2 = in[21]; p.w_ffn_in = in[22]; p.w_ffn_out = in[23]; p.g_final = in[24];
    p.out = (float*)d_out; p.ws = (unsigned char*)d_ws;
    void* args[] = {&p};
    hipError_t e = hipLaunchCooperativeKernel((const void*)fwd_megakernel, dim3(grid_blocks), dim3(NT), args, LDS_BYTES, stream);
    if (e != hipSuccess) fprintf(stderr, "cooperative launch failed: %s (grid %d)\n", hipGetErrorString(e), grid_blocks);
}
```

```cpp
#include <hip/hip_runtime.h>
#include <hip/hip_cooperative_groups.h>
#include <cstdio>
namespace cg = cooperative_groups;

#define LAS __attribute__((address_space(3)))
#define GAS __attribute__((address_space(1)))
typedef unsigned short bf16_t;
typedef short bf16x8 __attribute__((ext_vector_type(8)));
typedef float f32x4 __attribute__((ext_vector_type(4)));
typedef float f32x2 __attribute__((ext_vector_type(2)));
typedef unsigned u32x4 __attribute__((ext_vector_type(4)));
typedef unsigned u32x2 __attribute__((ext_vector_type(2)));

constexpr int D = 1024, NP = 16384, NS = 512, MT = NP + NS;
constexpr int SEQ = 2048, NB_P = 8, NB_S = 128, TS = 4;
constexpr int INC = 8200, DFF = 2816, NZ = 8192;
constexpr float EPS = 1e-6f;
constexpr int NWAVES = 8, NT = 512;
constexpr int LDS_BYTES = 139264;

constexpr size_t O_Y = 0, O_CONVP = 17301504, O_CP = 17350656, O_NP = 19447808, O_MP = 19456000,
                 O_CONVS = 19456032, O_CS = 20242464, O_NS = 53796896, O_MS = 53927968, O_GMV = 53928480;

constexpr size_t RSZ = (size_t)MT * D * 2;
constexpr size_t WS_CTL = 0;
constexpr size_t WS_PCNT = 16384;
constexpr size_t WS_WZ = 32768;
constexpr size_t WS_WPA = WS_WZ + (size_t)NZ * D * 2;
constexpr size_t WS_WPB = WS_WPA + (size_t)D * D * 2;
constexpr size_t WS_WO = WS_WPB + (size_t)D * D * 2;
constexpr size_t WS_WF1 = WS_WO + (size_t)D * D * 2;
constexpr size_t WS_WF2 = WS_WF1 + (size_t)2 * DFF * D * 2;
constexpr size_t WS_WSB = WS_WF2 + (size_t)D * DFF * 2;
constexpr size_t WS_G = WS_WSB + 4 * 128 * 128 * 2;
constexpr size_t WS_DEN = WS_G + (size_t)MT * 8 * 4;
constexpr size_t WS_H = WS_DEN + (size_t)MT * 4 * 4;
constexpr size_t WS_Z = WS_H + RSZ;
constexpr size_t WS_AOUT = WS_Z + 8 * RSZ;
constexpr size_t WS_BOUT = WS_AOUT + RSZ;
constexpr size_t WS_HM = WS_BOUT + RSZ;
constexpr size_t WS_QKC = WS_HM + RSZ;
constexpr size_t WS_GP = WS_QKC + 2 * RSZ;
constexpr size_t WS_XS = WS_GP + (size_t)NP * 4 * 16;
constexpr size_t WS_END = WS_XS + (size_t)NP * 4 * 4;

struct Params {
    const float *x_prompt, *x_sample, *state_conv, *state_C, *state_n, *state_m;
    const float *g_norm1, *w_in, *b_i, *b_f, *ln_g, *ln_b, *w_s, *b_s, *conv_w, *conv_b, *hn_g, *b_gate;
    const float *w_proj_a, *w_proj_b, *w_out, *g_norm2, *w_ffn_in, *w_ffn_out, *g_final;
    float* out; unsigned char* ws;
};

__device__ __forceinline__ unsigned pk2(float lo, float hi) { unsigned r; asm volatile("v_cvt_pk_bf16_f32 %0, %1, %2" : "=v"(r) : "v"(lo), "v"(hi)); return r; }
__device__ __forceinline__ float bflo(unsigned w) { return __uint_as_float(w << 16); }
__device__ __forceinline__ float bfhi(unsigned w) { return __uint_as_float(w & 0xffff0000u); }
__device__ __forceinline__ float wave_sum(float v) {
#pragma unroll
    for (int o = 1; o < 64; o <<= 1) v += __shfl_xor(v, o);
    return v;
}
__device__ __forceinline__ float sigmoid_f(float x) { return __builtin_amdgcn_rcpf(1.0f + __expf(-x)); }
__device__ __forceinline__ float silu_f(float x) { return x * sigmoid_f(x); }
#define LDS_BARRIER() do { asm volatile("s_waitcnt lgkmcnt(0)" ::: "memory"); __builtin_amdgcn_s_barrier(); asm volatile("" ::: "memory"); } while (0)
__device__ __forceinline__ void lds_fence() { asm volatile("s_waitcnt lgkmcnt(0)" ::: "memory"); }


#define XB_TMO      128
#define XB_XCNT(j)  (256  + 64 * (j))
#define XB_XSUB(j)  (1280 + 64 * (j))
#define XB_XGEN(j)  (2304 + 64 * (j))
#define XB_TOP      3328
#define XB_TOPGEN   3392
#define XCD_BAR_WORDS 3456
#define XB_SPIN_CAP (1u << 20)
__device__ __forceinline__ unsigned xb_ld(unsigned* p)              { return __hip_atomic_load(p, __ATOMIC_RELAXED, __HIP_MEMORY_SCOPE_AGENT); }
__device__ __forceinline__ unsigned xb_add(unsigned* p, unsigned v) { return __hip_atomic_fetch_add(p, v, __ATOMIC_RELAXED, __HIP_MEMORY_SCOPE_AGENT); }
__device__ __forceinline__ unsigned xb_xcc_id() { return (unsigned)__builtin_amdgcn_s_getreg((3 << 11) | 20) & 0xFu; }
#define XB_SPIN(cond, bar) do { unsigned _sp = 0; while (cond) { __builtin_amdgcn_s_sleep(1); \
    if ((++_sp & 255u) == 0u) { if (xb_ld(&(bar)[XB_TMO])) break; if (_sp > XB_SPIN_CAP) { atomicAdd(&(bar)[XB_TMO], 1u); break; } } } } while (0)
struct XcdBarrier { unsigned* bar; unsigned x; volatile LAS unsigned* st; };
__device__ __forceinline__ XcdBarrier xcd_barrier_post(unsigned* bar, volatile LAS unsigned* st) {
    XcdBarrier b; b.bar = bar; b.x = xb_xcc_id(); b.st = st;
    if (threadIdx.x == 0) (void)xb_add(&bar[XB_XCNT(b.x)], 1u);
    return b;
}
__device__ __forceinline__ void xcd_barrier_complete(unsigned* bar, unsigned x, unsigned& nloc, unsigned& nx) {
    const unsigned G = gridDim.x * gridDim.y * gridDim.z;
    unsigned sum, cnt, mine, sp = 0u;
    for (;;) {
        sum = 0u; cnt = 0u; mine = 0u;
#pragma unroll
        for (unsigned j = 0; j < 16; ++j) { const unsigned c = xb_ld(&bar[XB_XCNT(j)]); sum += c; cnt += (c > 0u) ? 1u : 0u; mine = (j == x) ? c : mine; }
        if (sum == G) break;
        __builtin_amdgcn_s_sleep(1);
        if ((++sp & 255u) == 0u) { if (xb_ld(&bar[XB_TMO])) break; if (sp > XB_SPIN_CAP) { atomicAdd(&bar[XB_TMO], 1u); break; } }
    }
    nloc = mine > 0u ? mine : 1u; nx = cnt > 0u ? cnt : 1u;
}
__device__ __forceinline__ void xcd_barrier(const XcdBarrier& b) {
    asm volatile("s_waitcnt vmcnt(0)" ::: "memory");
    __syncthreads();
    if (threadIdx.x == 0) {
        unsigned* bar = b.bar;
        __builtin_amdgcn_s_waitcnt(0);
        unsigned nloc = b.st[0], nx = b.st[1];
        if (nloc == 0u) { xcd_barrier_complete(bar, b.x, nloc, nx); b.st[0] = nloc; b.st[1] = nx; }
        const unsigned old = xb_add(&bar[XB_XSUB(b.x)], 1u);
        const unsigned gen = old / nloc;
        if (old + 1u == (gen + 1u) * nloc) {
            __builtin_amdgcn_fence(__ATOMIC_RELEASE, "agent");
            asm volatile("s_waitcnt vmcnt(0)" ::: "memory");
            const unsigned og = xb_add(&bar[XB_TOP], 1u);
            const unsigned tg = og / nx;
            if (og + 1u == (tg + 1u) * nx) xb_add(&bar[XB_TOPGEN], 1u);
            else XB_SPIN(xb_ld(&bar[XB_TOPGEN]) == tg, bar);
            __builtin_amdgcn_fence(__ATOMIC_ACQUIRE, "agent");
            xb_add(&bar[XB_XGEN(b.x)], 1u);
            asm volatile("s_waitcnt vmcnt(0)" ::: "memory");
        } else {
            XB_SPIN(xb_ld(&bar[XB_XGEN(b.x)]) == gen, bar);
            __builtin_amdgcn_fence(__ATOMIC_ACQUIRE, "agent");
            asm volatile("s_waitcnt vmcnt(0)" ::: "memory");
        }
    }
    __syncthreads();
}

template <int K>
__device__ __forceinline__ void small_tile_mma(const bf16_t* A, const bf16_t* Bt, int r0, int c0, int wid, int fr, int fq, f32x4 (&acc)[4][2]) {
    constexpr int KS = K / 8;
    const bf16_t* ap = A + (size_t)(r0 + fr) * K + wid * KS + 8 * fq;
    const bf16_t* bp = Bt + (size_t)(c0 + fr) * K + wid * KS + 8 * fq;
#pragma unroll 2
    for (int ks = 0; ks < KS; ks += 32) {
        bf16x8 a[4], b[2];
#pragma unroll
        for (int mi = 0; mi < 4; ++mi) a[mi] = *(const GAS bf16x8*)(ap + (size_t)(16 * mi) * K + ks);
#pragma unroll
        for (int ni = 0; ni < 2; ++ni) b[ni] = *(const GAS bf16x8*)(bp + (size_t)(16 * ni) * K + ks);
#pragma unroll
        for (int mi = 0; mi < 4; ++mi)
#pragma unroll
            for (int ni = 0; ni < 2; ++ni) acc[mi][ni] = __builtin_amdgcn_mfma_f32_16x16x32_bf16(b[ni], a[mi], acc[mi][ni], 0, 0, 0);
    }
}
__device__ __forceinline__ f32x4 small_tile_reduce(LAS unsigned char* lds, const f32x4 (&acc)[4][2], int wid, int fr, int fq) {
    LAS float* RED = (LAS float*)lds;
    __syncthreads();
#pragma unroll
    for (int mi = 0; mi < 4; ++mi)
#pragma unroll
        for (int ni = 0; ni < 2; ++ni) *(LAS f32x4*)(RED + (wid * 64 + 16 * mi + fr) * 32 + 16 * ni + 4 * fq) = acc[mi][ni];
    __syncthreads();
    const int tid = threadIdx.x, row = tid >> 3, cq = tid & 7;
    f32x4 s = (f32x4){0.f, 0.f, 0.f, 0.f};
#pragma unroll
    for (int w = 0; w < 8; ++w) s += *(const LAS f32x4*)(RED + (w * 64 + row) * 32 + 4 * cq);
    return s;
}
#define ZERO_ACC42(acc) _Pragma("unroll") for (int _m = 0; _m < 4; ++_m) _Pragma("unroll") for (int _n = 0; _n < 2; ++_n) acc[_m][_n] = (f32x4){0.f, 0.f, 0.f, 0.f}

namespace pg8 {
constexpr int BM = 256, BK = 64, HALF = 128, HTB = HALF * BK * 2, STAGE_BYTES = 8 * HTB, NXCD = 8, WGM = 8;
__device__ __forceinline__ int lds_byte(int r, int c) { const int st = (r >> 4) * 2 + (c >> 5), rr = r & 15, cc = c & 31, ob = rr * 64 + cc * 2; return st * 1024 + (ob ^ (((ob >> 9) & 1) << 5)); }
__device__ __forceinline__ void stage_rc(int b, int& R, int& C) { const int st = b / 1024, sb = b % 1024, swz = sb ^ (((sb >> 9) & 1) << 5); R = (st >> 1) * 16 + swz / 64; C = (st & 1) * 32 + (swz % 64) / 2; }
__device__ __forceinline__ int perm32(int rho) { const int n = rho >> 4, i = rho & 15; return 8 * (i >> 2) + 4 * n + (i & 3); }
struct Unit { int pm, pn; };
struct Gemm { const bf16_t* A; const bf16_t* Bt; int M, N, K; };
struct StaticOrder {
    int nM, nN, nwg, G, c;
    __device__ void init(int M, int N, int G_, int c_) { nM = M / BM; nN = N / BM; nwg = nM * nN; G = G_; c = c_; }
    __device__ bool next(int i, Unit& u) const {
        const long L = (long)i * G + c; if (L >= nwg) return false;
        int wgid = (int)L; { const int q = nwg / NXCD, r = nwg % NXCD, xcd = wgid % NXCD, off = wgid / NXCD; wgid = (xcd < r ? xcd * (q + 1) : r * (q + 1) + (xcd - r) * q) + off; }
        const int nig = WGM * nN, gid = wgid / nig, fm = gid * WGM, gsz = (nM - fm) < WGM ? (nM - fm) : WGM;
        u.pm = fm + ((wgid % nig) % gsz); u.pn = (wgid % nig) / gsz; return true;
    }
    __device__ __forceinline__ void a_ready(const Unit&) const {}
    __device__ __forceinline__ void done(const Unit&) const {}
};

template <class Epi, class Sched>
__device__ __forceinline__ void gemm_phase(LAS unsigned char* lds, const Gemm g, const Sched& S, const Epi& E) {
    const int tid = threadIdx.x, wid = __builtin_amdgcn_readfirstlane(tid >> 6), lane = tid & 63, wr = wid >> 2, wc = wid & 3, fr = lane & 15, fq = lane >> 4;
    const int K = g.K, nt = K / BK;
    unsigned voffA[2], voffB[2];
#pragma unroll
    for (int i = 0; i < 2; ++i) { int R, C; stage_rc(tid * 16 + i * 8192, R, C); const int Rb = Epi::PERM ? ((R & ~31) + perm32(R & 31)) : R;
        voffA[i] = (unsigned)(R * K + C) * 2u; voffB[i] = (unsigned)(Rb * K + C) * 2u; }
    const size_t kstep = (size_t)(BK * 2);
    const size_t hstep = (size_t)HALF * K * 2;
    const size_t tstep = 2 * hstep;
    const unsigned ldsw = (unsigned)wid * 1024u;
    const int aoff = lds_byte(wr * 64 + fr, fq * 8), boff = lds_byte(wc * 32 + fr, fq * 8);
#define PG8_SA(b, h) (((b) * 2 + (h)) * HTB)
#define PG8_SB(b, h) ((4 + (b) * 2 + (h)) * HTB)
#define PG8_STAGE(bufoff, gbase, voff) do { _Pragma("unroll") for (int _i = 0; _i < 2; ++_i) \
        __builtin_amdgcn_global_load_lds((const unsigned*)((const char*)(gbase) + (voff)[_i]), (LAS unsigned*)(lds + (bufoff) + ldsw + _i * 8192), 16, 0, 0); } while (0)
#define PG8_LDA(dst, b, h) do { _Pragma("unroll") for (int m = 0; m < 4; ++m) _Pragma("unroll") for (int k = 0; k < 2; ++k) dst[m][k] = *(const LAS bf16x8*)(lds + PG8_SA(b, h) + aoff + m * 2048 + k * 1024); } while (0)
#define PG8_LDB(dst, b, h) do { _Pragma("unroll") for (int n = 0; n < 2; ++n) _Pragma("unroll") for (int k = 0; k < 2; ++k) dst[n][k] = *(const LAS bf16x8*)(lds + PG8_SB(b, h) + boff + n * 2048 + k * 1024); } while (0)
#define PG8_MMA(ai, bj, At, Bt) do { __builtin_amdgcn_s_setprio(1); _Pragma("unroll") for (int m = 0; m < 4; ++m) _Pragma("unroll") for (int n = 0; n < 2; ++n) _Pragma("unroll") for (int k = 0; k < 2; ++k) \
        acc[ai][bj][m][n] = __builtin_amdgcn_mfma_f32_16x16x32_bf16(Bt[n][k], At[m][k], acc[ai][bj][m][n], 0, 0, 0); __builtin_amdgcn_s_setprio(0); } while (0)
#define PG8_WAIT_V(n) asm volatile("s_waitcnt vmcnt(" #n ")" ::: "memory")
#define PG8_WAIT_L(n) asm volatile("s_waitcnt lgkmcnt(" #n ")" ::: "memory")
#define PG8_BAR __builtin_amdgcn_s_barrier()
#define PG8_SCHED __builtin_amdgcn_sched_barrier(0)
    Unit cur, nxt; int ui = 0;
    if (!S.next(0, cur)) return;
    f32x4 acc[2][2][4][2];
#pragma unroll
    for (int a = 0; a < 2; ++a)
#pragma unroll
        for (int b = 0; b < 2; ++b)
#pragma unroll
            for (int m = 0; m < 4; ++m)
#pragma unroll
                for (int n = 0; n < 2; ++n) acc[a][b][m][n] = (f32x4){0.f, 0.f, 0.f, 0.f};
    bf16x8 At[4][2], B0[2][2], B1[2][2];
    const char* cA = (const char*)g.A + (size_t)cur.pm * tstep; const char* cB = (const char*)g.Bt + (size_t)cur.pn * tstep;
    S.a_ready(cur);
    PG8_STAGE(PG8_SB(0, 0), cB, voffB); PG8_STAGE(PG8_SA(0, 0), cA, voffA); PG8_STAGE(PG8_SB(0, 1), cB + hstep, voffB); PG8_STAGE(PG8_SA(0, 1), cA + hstep, voffA);
    if (wr == 1) PG8_BAR;
    PG8_WAIT_V(4); PG8_BAR;
    PG8_STAGE(PG8_SB(1, 0), cB + kstep, voffB); PG8_STAGE(PG8_SA(1, 0), cA + kstep, voffA); PG8_STAGE(PG8_SB(1, 1), cB + hstep + kstep, voffB);
    PG8_WAIT_V(6); PG8_BAR;
    for (;;) {
        const bool has_next = S.next(ui + 1, nxt);
        const char* nA = has_next ? (const char*)g.A + (size_t)nxt.pm * tstep : cA; const char* nB = has_next ? (const char*)g.Bt + (size_t)nxt.pn * tstep : cB;
        for (int t = 0; t < nt; t += 2) {
            const bool last = (t == nt - 2);
            const char* a1 = cA + (size_t)(t + 1) * kstep;
            const char* a2 = last ? nA : cA + (size_t)(t + 2) * kstep; const char* b2 = last ? nB : cB + (size_t)(t + 2) * kstep;
            const char* a3 = a2 + kstep; const char* b3 = b2 + kstep;
            if (last && has_next) S.a_ready(nxt);
            PG8_LDB(B0, 0, 0); PG8_SCHED; PG8_LDA(At, 0, 0); PG8_STAGE(PG8_SA(1, 1), a1 + hstep, voffA);
            PG8_WAIT_L(8); PG8_BAR; PG8_WAIT_L(0); PG8_MMA(0, 0, At, B0); PG8_BAR; PG8_SCHED;
            PG8_LDB(B1, 0, 1); PG8_STAGE(PG8_SB(0, 0), b2, voffB);
            PG8_BAR; PG8_WAIT_L(0); PG8_MMA(0, 1, At, B1); PG8_BAR;
            PG8_LDA(At, 0, 1); PG8_STAGE(PG8_SA(0, 0), a2, voffA);
            PG8_BAR; PG8_WAIT_L(0); PG8_MMA(1, 0, At, B0); PG8_BAR; PG8_SCHED;
            PG8_STAGE(PG8_SB(0, 1), b2 + hstep, voffB);
            PG8_WAIT_V(6); PG8_BAR; PG8_MMA(1, 1, At, B1); PG8_BAR;
            PG8_LDB(B0, 1, 0); PG8_SCHED; PG8_LDA(At, 1, 0); PG8_STAGE(PG8_SA(0, 1), a2 + hstep, voffA);
            PG8_WAIT_L(8); PG8_BAR; PG8_WAIT_L(0); PG8_MMA(0, 0, At, B0); PG8_BAR; PG8_SCHED;
            PG8_LDB(B1, 1, 1); PG8_STAGE(PG8_SB(1, 0), b3, voffB);
            PG8_BAR; PG8_WAIT_L(0); PG8_MMA(0, 1, At, B1); PG8_BAR;
            PG8_LDA(At, 1, 1); PG8_STAGE(PG8_SA(1, 0), a3, voffA);
            PG8_BAR; PG8_WAIT_L(0); PG8_MMA(1, 0, At, B0); PG8_BAR; PG8_SCHED;
            PG8_STAGE(PG8_SB(1, 1), b3 + hstep, voffB);
            PG8_WAIT_V(6); PG8_BAR; PG8_MMA(1, 1, At, B1); PG8_BAR;
        }
        if constexpr (!Epi::AFTER_DRAIN) { E(acc, cur, wr, wc, fr, fq); S.done(cur); }
        if (!has_next) break;
#pragma unroll
        for (int a = 0; a < 2; ++a)
#pragma unroll
            for (int b = 0; b < 2; ++b)
#pragma unroll
                for (int m = 0; m < 4; ++m)
#pragma unroll
                    for (int n = 0; n < 2; ++n) acc[a][b][m][n] = (f32x4){0.f, 0.f, 0.f, 0.f};
        cur = nxt; cA = nA; cB = nB; ++ui;
    }
    PG8_WAIT_V(0);
    if (wr == 0) PG8_BAR;
    PG8_BAR;
    if constexpr (Epi::AFTER_DRAIN) { E.fused(acc, cur, wr, wc, fr, fq, lds, wid, lane); S.done(cur); }
#undef PG8_SA
#undef PG8_SB
#undef PG8_STAGE
#undef PG8_LDA
#undef PG8_LDB
#undef PG8_MMA
#undef PG8_WAIT_V
#undef PG8_WAIT_L
#undef PG8_BAR
#undef PG8_SCHED
}
}
using pg8::Unit; using pg8::HALF; using pg8::BM;

__device__ __forceinline__ f32x2 gelu_pk(f32x2 v) {
    const f32x2 av = __builtin_elementwise_abs(v), d = av * 0.2316418882f + 1.0f;
    f32x2 t; t.x = __builtin_amdgcn_rcpf(d.x); t.y = __builtin_amdgcn_rcpf(d.y);
    f32x2 q = t * 0.5307027145f + (-0.7265760135f); q = q * t + 0.7107068705f; q = q * t + (-0.142248368f); q = q * t + 0.127414796f; q = q * t;
    const f32x2 s = (v * v) * (-0.72134752044f);
    f32x2 e; e.x = __builtin_amdgcn_exp2f(s.x); e.y = __builtin_amdgcn_exp2f(s.y);
    const f32x2 m = v * (q * e), r = v - m;
    f32x2 o; o.x = v.x < 0.f ? m.x : r.x; o.y = v.y < 0.f ? m.y : r.y; return o;
}

struct EpiZ {
    static constexpr bool PERM = true, AFTER_DRAIN = false;
    bf16_t* Z; const float* b_gate;
    __device__ __forceinline__ void operator()(const f32x4 (&acc)[2][2][4][2], const Unit& u, int wr, int wc, int fr, int fq) const {
        const int sec = u.pn >> 2; int colt = (u.pn & 3) * BM; bf16_t* base; int ldc;
        if (sec == 2 || sec == 3) { base = Z + (size_t)2 * MT * D; ldc = 2 * D; colt += (sec - 2) * D; } else { base = Z + (size_t)sec * MT * D; ldc = D; }
        const int row0 = u.pm * BM + wr * 64 + fr, col0 = colt + wc * 32 + 8 * fq;
        const int gcol0 = (u.pn & 3) * BM + wc * 32 + 8 * fq;
        f32x4 bv[2][2];
#pragma unroll
        for (int bj = 0; bj < 2; ++bj)
#pragma unroll
            for (int n = 0; n < 2; ++n) bv[bj][n] = (sec >= 6) ? *(const GAS f32x4*)(b_gate + (sec - 6) * D + gcol0 + bj * HALF + 4 * n) : (f32x4){0.f, 0.f, 0.f, 0.f};
#pragma unroll
        for (int ai = 0; ai < 2; ++ai)
#pragma unroll
            for (int m = 0; m < 4; ++m) { bf16_t* rowp = base + (size_t)(row0 + ai * HALF + m * 16) * ldc + col0;
#pragma unroll
                for (int bj = 0; bj < 2; ++bj) { f32x4 v0 = acc[ai][bj][m][0] + bv[bj][0], v1 = acc[ai][bj][m][1] + bv[bj][1];
                    if (false) { }
                    else if (sec >= 6) {
#pragma unroll
                        for (int j = 0; j < 4; ++j) { v0[j] = sigmoid_f(v0[j]); v1[j] = sigmoid_f(v1[j]); } }
                    u32x4 w; w.x = pk2(v0[0], v0[1]); w.y = pk2(v0[2], v0[3]); w.z = pk2(v1[0], v1[1]); w.w = pk2(v1[2], v1[3]);
                    *(GAS u32x4*)(rowp + bj * HALF) = w; } }
    }
};
struct EpiT1 {
    static constexpr bool PERM = true, AFTER_DRAIN = false;
    bf16_t* T; const bf16_t* SG;
    __device__ __forceinline__ void operator()(const f32x4 (&acc)[2][2][4][2], const Unit& u, int wr, int wc, int fr, int fq) const {
        const int row0 = u.pm * BM + wr * 64 + fr, col0 = u.pn * BM + wc * 32 + 8 * fq;
#pragma unroll
        for (int ai = 0; ai < 2; ++ai)
#pragma unroll
            for (int m = 0; m < 4; ++m) { const size_t off = (size_t)(row0 + ai * HALF + m * 16) * D + col0;
#pragma unroll
                for (int bj = 0; bj < 2; ++bj) { const u32x4 s = *(const GAS u32x4*)(SG + off + bj * HALF);
                    const f32x4 o0 = acc[ai][bj][m][0], o1 = acc[ai][bj][m][1];
                    u32x4 w; w.x = pk2(o0[0] * bflo(s.x), o0[1] * bfhi(s.x)); w.y = pk2(o0[2] * bflo(s.y), o0[3] * bfhi(s.y));
                    w.z = pk2(o1[0] * bflo(s.z), o1[1] * bfhi(s.z)); w.w = pk2(o1[2] * bflo(s.w), o1[3] * bfhi(s.w));
                    *(GAS u32x4*)(T + off + bj * HALF) = w; } }
    }
};
struct EpiT2 {
    static constexpr bool PERM = true, AFTER_DRAIN = false;
    const bf16_t* T; const bf16_t* SG; bf16_t* O;
    __device__ __forceinline__ void operator()(const f32x4 (&acc)[2][2][4][2], const Unit& u, int wr, int wc, int fr, int fq) const {
        const int row0 = u.pm * BM + wr * 64 + fr, col0 = u.pn * BM + wc * 32 + 8 * fq;
#pragma unroll
        for (int ai = 0; ai < 2; ++ai)
#pragma unroll
            for (int m = 0; m < 4; ++m) { const size_t off = (size_t)(row0 + ai * HALF + m * 16) * D + col0;
#pragma unroll
                for (int bj = 0; bj < 2; ++bj) { const u32x4 s = *(const GAS u32x4*)(SG + off + bj * HALF), t = *(const GAS u32x4*)(T + off + bj * HALF);
                    const f32x4 o0 = acc[ai][bj][m][0], o1 = acc[ai][bj][m][1];
                    u32x4 w; w.x = pk2(bflo(t.x) + o0[0] * bflo(s.x), bfhi(t.x) + o0[1] * bfhi(s.x)); w.y = pk2(bflo(t.y) + o0[2] * bflo(s.y), bfhi(t.y) + o0[3] * bfhi(s.y));
                    w.z = pk2(bflo(t.z) + o1[0] * bflo(s.z), bfhi(t.z) + o1[1] * bfhi(s.z)); w.w = pk2(bflo(t.w) + o1[2] * bflo(s.w), bfhi(t.w) + o1[3] * bfhi(s.w));
                    *(GAS u32x4*)(O + off + bj * HALF) = w; } }
    }
};
template <bool FIRST> struct EpiRes {
    static constexpr bool PERM = true, AFTER_DRAIN = false;
    const float* xp; bf16_t* XB;
    __device__ __forceinline__ void operator()(const f32x4 (&acc)[2][2][4][2], const Unit& u, int wr, int wc, int fr, int fq) const {
        const int row0 = u.pm * BM + wr * 64 + fr, col0 = u.pn * BM + wc * 32 + 8 * fq;
#pragma unroll
        for (int ai = 0; ai < 2; ++ai)
#pragma unroll
            for (int m = 0; m < 4; ++m) { const size_t off = (size_t)(row0 + ai * HALF + m * 16) * D + col0;
#pragma unroll
                for (int bj = 0; bj < 2; ++bj) { f32x4 b0, b1;
                    if (FIRST) { b0 = *(const GAS f32x4*)(xp + off + bj * HALF); b1 = *(const GAS f32x4*)(xp + off + bj * HALF + 4); }
                    else { const u32x4 t = *(const GAS u32x4*)(XB + off + bj * HALF); b0 = (f32x4){bflo(t.x), bfhi(t.x), bflo(t.y), bfhi(t.y)}; b1 = (f32x4){bflo(t.z), bfhi(t.z), bflo(t.w), bfhi(t.w)}; }
                    const f32x4 o0 = b0 + acc[ai][bj][m][0], o1 = b1 + acc[ai][bj][m][1];
                    u32x4 w; w.x = pk2(o0[0], o0[1]); w.y = pk2(o0[2], o0[3]); w.z = pk2(o1[0], o1[1]); w.w = pk2(o1[2], o1[3]);
                    *(GAS u32x4*)(XB + off + bj * HALF) = w; } }
    }
};
template <bool FIRST> struct EpiNorm {
    static constexpr bool PERM = true, AFTER_DRAIN = true;
    const float* xp; bf16_t* XB; bf16_t* H2; float* Y; const float* gain; float* xs; unsigned* cnt; unsigned* tmo; unsigned want;
    __device__ __forceinline__ void fused(f32x4 (&acc)[2][2][4][2], const Unit& u, int wr, int wc, int fr, int fq, LAS unsigned char* lds, int wid, int lane) const {
        LAS float* P = (LAS float*)lds;
        LAS float* S = (LAS float*)(lds + 4096);
        const int row0 = u.pm * BM + wr * 64 + fr, col0 = u.pn * BM + wc * 32 + 8 * fq;
#pragma unroll
        for (int ai = 0; ai < 2; ++ai)
#pragma unroll
            for (int m = 0; m < 4; ++m) { const size_t off = (size_t)(row0 + ai * HALF + m * 16) * D + col0; float ss = 0.f;
#pragma unroll
                for (int bj = 0; bj < 2; ++bj) { f32x4& a0 = acc[ai][bj][m][0]; f32x4& a1 = acc[ai][bj][m][1];
                    if (FIRST) { a0 += *(const GAS f32x4*)(xp + off + bj * HALF); a1 += *(const GAS f32x4*)(xp + off + bj * HALF + 4);
                        u32x4 w; w.x = pk2(a0[0], a0[1]); w.y = pk2(a0[2], a0[3]); w.z = pk2(a1[0], a1[1]); w.w = pk2(a1[2], a1[3]); *(GAS u32x4*)(XB + off + bj * HALF) = w; }
                    else { const u32x4 t = *(const GAS u32x4*)(XB + off + bj * HALF);
                        a0[0] += bflo(t.x); a0[1] += bfhi(t.x); a0[2] += bflo(t.y); a0[3] += bfhi(t.y); a1[0] += bflo(t.z); a1[1] += bfhi(t.z); a1[2] += bflo(t.w); a1[3] += bfhi(t.w); }
                    ss += ((a0[0] * a0[0] + a0[1] * a0[1]) + (a0[2] * a0[2] + a0[3] * a0[3])) + ((a1[0] * a1[0] + a1[1] * a1[1]) + (a1[2] * a1[2] + a1[3] * a1[3])); }
                ss += __shfl_xor(ss, 16); ss += __shfl_xor(ss, 32);
                if (fq == 0) P[(ai * HALF + wr * 64 + m * 16 + fr) * 4 + wc] = ss; }
        asm volatile("s_waitcnt lgkmcnt(0)" ::: "memory"); __builtin_amdgcn_s_barrier(); asm volatile("" ::: "memory");
        const int row = wid * 32 + (lane & 31);
        if (lane < 32) { const f32x4 q = *(const LAS f32x4*)(P + row * 4);
            __hip_atomic_store(xs + ((size_t)(u.pm * BM + row) * 4 + u.pn), (q[0] + q[1]) + (q[2] + q[3]), __ATOMIC_RELAXED, __HIP_MEMORY_SCOPE_AGENT); }
        asm volatile("s_waitcnt vmcnt(0)" ::: "memory");
        if (lane == 0) (void)__hip_atomic_fetch_add(cnt + 64 * u.pm, 1u, __ATOMIC_RELAXED, __HIP_MEMORY_SCOPE_AGENT);
        if (wid == 0) { unsigned sp = 0;
            while ((unsigned)__builtin_amdgcn_readfirstlane(__hip_atomic_load(cnt + 64 * u.pm, __ATOMIC_RELAXED, __HIP_MEMORY_SCOPE_AGENT)) < want) {
                __builtin_amdgcn_s_sleep(2); if (++sp > (1u << 20)) { if (lane == 0) __hip_atomic_store(tmo, 1u, __ATOMIC_RELAXED, __HIP_MEMORY_SCOPE_AGENT); break; } }
            __builtin_amdgcn_fence(__ATOMIC_ACQUIRE, "agent"); }
        asm volatile("s_waitcnt vmcnt(0) lgkmcnt(0)" ::: "memory"); __builtin_amdgcn_s_barrier(); asm volatile("" ::: "memory");
        if (lane < 32) { const float* sl = xs + (size_t)(u.pm * BM + row) * 4; float t = 0.f;
#pragma unroll
            for (int j = 0; j < 4; ++j) t += __hip_atomic_load(sl + j, __ATOMIC_RELAXED, __HIP_MEMORY_SCOPE_AGENT);
            S[row] = rsqrtf(t * (1.0f / D) + EPS); }
        asm volatile("s_waitcnt vmcnt(0) lgkmcnt(0)" ::: "memory"); __builtin_amdgcn_s_barrier(); asm volatile("" ::: "memory");
        f32x4 gv[2][2];
#pragma unroll
        for (int bj = 0; bj < 2; ++bj) { gv[bj][0] = *(const GAS f32x4*)(gain + col0 + bj * HALF); gv[bj][1] = *(const GAS f32x4*)(gain + col0 + bj * HALF + 4); }
#pragma unroll
        for (int ai = 0; ai < 2; ++ai)
#pragma unroll
            for (int m = 0; m < 4; ++m) { const int r = ai * HALF + wr * 64 + m * 16 + fr; const float rs = S[r]; const size_t off = (size_t)(u.pm * BM + r) * D + col0;
#pragma unroll
                for (int bj = 0; bj < 2; ++bj) { const f32x4 o0 = acc[ai][bj][m][0] * rs * gv[bj][0], o1 = acc[ai][bj][m][1] * rs * gv[bj][1];
                    if (FIRST) { u32x4 w; w.x = pk2(o0[0], o0[1]); w.y = pk2(o0[2], o0[3]); w.z = pk2(o1[0], o1[1]); w.w = pk2(o1[2], o1[3]); *(GAS u32x4*)(H2 + off + bj * HALF) = w; }
                    else { *(GAS f32x4*)(Y + off + bj * HALF) = o0; *(GAS f32x4*)(Y + off + bj * HALF + 4) = o1; } } }
    }
};
struct EpiFfn {
    static constexpr bool PERM = true, AFTER_DRAIN = false;
    bf16_t* ACT;
    __device__ __forceinline__ void operator()(const f32x4 (&acc)[2][2][4][2], const Unit& u, int wr, int wc, int fr, int fq) const {
        const int row0 = u.pm * BM + wr * 64 + fr, col0 = u.pn * HALF + wc * 32 + 8 * fq;
#pragma unroll
        for (int ai = 0; ai < 2; ++ai)
#pragma unroll
            for (int m = 0; m < 4; ++m) { bf16_t* rowp = ACT + (size_t)(row0 + ai * HALF + m * 16) * DFF + col0;
                f32x4 o0, o1;
#pragma unroll
                for (int j = 0; j < 4; ++j) { o0[j] = silu_f(acc[ai][0][m][0][j]) * acc[ai][1][m][0][j]; o1[j] = silu_f(acc[ai][0][m][1][j]) * acc[ai][1][m][1][j]; }
                u32x4 w; w.x = pk2(o0[0], o0[1]); w.y = pk2(o0[2], o0[3]); w.z = pk2(o1[0], o1[1]); w.w = pk2(o1[2], o1[3]);
                *(u32x4*)rowp = w; }
    }
};

__device__ __forceinline__ void transpose_item(const float* W, int ldw, int K, bf16_t* WT, int k0, int srccol0, int dstrow0, LAS float* scr, int lane) {
    { const int kr = lane >> 3, nq = lane & 7;
      f32x4 wv[8];
#pragma unroll
      for (int i = 0; i < 8; ++i) wv[i] = *(const GAS f32x4*)(W + (size_t)(k0 + 8 * i + kr) * ldw + srccol0 + 4 * nq);
#pragma unroll
      for (int i = 0; i < 8; ++i) { LAS float* d = scr + (8 * i + kr) * 33 + 4 * nq; d[0] = wv[i][0]; d[1] = wv[i][1]; d[2] = wv[i][2]; d[3] = wv[i][3]; } }
    lds_fence();
    const int c = lane & 7;
#pragma unroll
    for (int j = 0; j < 4; ++j) { const int n = (lane >> 3) + 8 * j; const LAS float* s = scr + (8 * c) * 33 + n;
        u32x4 o; o.x = pk2(s[0 * 33], s[1 * 33]); o.y = pk2(s[2 * 33], s[3 * 33]); o.z = pk2(s[4 * 33], s[5 * 33]); o.w = pk2(s[6 * 33], s[7 * 33]);
        *(GAS u32x4*)(WT + (size_t)(dstrow0 + n) * K + k0 + 8 * c) = o; }
    lds_fence();
}

__device__ __forceinline__ void phase0(const Params& p, LAS unsigned char* lds) {
    const int tid = threadIdx.x, lane = tid & 63, wid = tid >> 6;
    const int gw = blockIdx.x * NWAVES + wid, NGW = gridDim.x * NWAVES;
    unsigned char* ws = p.ws;
    LAS float* scr = (LAS float*)(lds + wid * 8448);
    LAS float* gwl = (LAS float*)(lds + 69632);
    for (int i = tid; i < 8192; i += NT) { const int k = i >> 3, c = i & 7; gwl[c * 1024 + k] = p.w_in[(size_t)k * INC + 6144 + c]; }
    for (int it = gw; it < 16 * 256; it += NGW) { const int kb = it / 256, nb = it % 256, n0 = nb * 32; transpose_item(p.w_in, INC, D, (bf16_t*)(ws + WS_WZ), kb * 64, n0 < 6144 ? n0 : n0 + 8, n0, scr, lane); }
    { bf16_t* wsb = (bf16_t*)(ws + WS_WSB);
      for (int i = blockIdx.x * NT + tid; i < 4 * 128 * 128 / 2; i += gridDim.x * NT) { const int e = 2 * i, s = e & 127, t = (e >> 7) & 127;
          const float a = s <= t ? p.w_s[e] : 0.f, b = (s + 1) <= t ? p.w_s[e + 1] : 0.f; ((unsigned*)wsb)[i] = pk2(a, b); } }
    __syncthreads();
    bf16_t* H = (bf16_t*)(ws + WS_H); float* G = (float*)(ws + WS_G);
    f32x4 g1v[4];
#pragma unroll
    for (int j = 0; j < 4; ++j) g1v[j] = ((const GAS f32x4*)p.g_norm1)[lane + 64 * j];
    for (int row0 = gw; row0 < MT; row0 += 2 * NGW) {
        f32x4 vv[2][4];
#pragma unroll
        for (int rr = 0; rr < 2; ++rr) { const int row = (row0 + rr * NGW < MT) ? row0 + rr * NGW : row0;
            const GAS float* xr = row < NP ? (const GAS float*)p.x_prompt + (size_t)row * D : (const GAS float*)p.x_sample + (size_t)(row - NP) * D;
#pragma unroll
            for (int j = 0; j < 4; ++j) vv[rr][j] = ((const GAS f32x4*)xr)[lane + 64 * j]; }
#pragma unroll
        for (int rr = 0; rr < 2; ++rr) { const int row = row0 + rr * NGW; if (row < MT) {
            f32x4 v[4]; float ss = 0.f;
#pragma unroll
            for (int j = 0; j < 4; ++j) { v[j] = vv[rr][j]; ss += (v[j][0] * v[j][0] + v[j][1] * v[j][1]) + (v[j][2] * v[j][2] + v[j][3] * v[j][3]); }
            const float r = rsqrtf(wave_sum(ss) * (1.0f / D) + EPS);
#pragma unroll
            for (int j = 0; j < 4; ++j) { v[j] = v[j] * r * g1v[j];
                u32x2 o; o.x = pk2(v[j][0], v[j][1]); o.y = pk2(v[j][2], v[j][3]); ((GAS u32x2*)((GAS bf16_t*)H + (size_t)row * D))[lane + 64 * j] = o; }
            float ga[8];
#pragma unroll
            for (int c = 0; c < 8; ++c) { float a = 0.f;
#pragma unroll
                for (int j = 0; j < 4; ++j) { const f32x4 w4 = ((const LAS f32x4*)(gwl + c * 1024))[lane + 64 * j]; a += (v[j][0] * w4[0] + v[j][1] * w4[1]) + (v[j][2] * w4[2] + v[j][3] * w4[3]); }
                ga[c] = wave_sum(a); }
            if (lane == 0) {
#pragma unroll
                for (int c = 0; c < 4; ++c) G[(size_t)row * 8 + c] = ga[c] + p.b_i[c];
#pragma unroll
                for (int c = 0; c < 4; ++c) { const float xx = ga[4 + c] + p.b_f[c]; G[(size_t)row * 8 + 4 + c] = fminf(xx, 0.f) - log1pf(expf(-fabsf(xx))); }
            } } }
    }
}

constexpr int QS_LD = 264, CS_LD = 264;
constexpr int OFF_QS = 0, OFF_KK = 33792, OFF_VT = 70656, OFF_SS = 82176, OFF_CS = 91392, OFF_GT = 133632;

__device__ __forceinline__ void load_raw4(float (&r)[4], const bf16_t* QK, const float* sconv, int rel, size_t rowbase, int col) {
    if (rel >= 0) { const u32x2 w = *(const GAS u32x2*)(QK + (rowbase + rel) * (2 * D) + col);
        r[0] = bflo(w.x); r[1] = bfhi(w.x); r[2] = bflo(w.y); r[3] = bfhi(w.y); }
    else if (sconv) { const f32x4 a = *(const GAS f32x4*)(sconv + (size_t)(3 + rel) * (2 * D) + col);
        r[0] = a[0]; r[1] = a[1]; r[2] = a[2]; r[3] = a[3]; }
    else { r[0] = 0.f; r[1] = 0.f; r[2] = 0.f; r[3] = 0.f; }
}
__device__ __forceinline__ void conv_silu_4x4(u32x2 (&out)[4], const Params& p, const bf16_t* QK, const float* sconv, int rel0, size_t rowbase, int col, float scale) {
    f32x4 acc[4];
    { const f32x4 b0 = *(const GAS f32x4*)(p.conv_b + col);
#pragma unroll
      for (int i = 0; i < 4; ++i) acc[i] = b0; }
    f32x4 w[4];
#pragma unroll
    for (int j = 0; j < 4; ++j) w[j] = *(const GAS f32x4*)(p.conv_w + (size_t)j * 2 * D + col);
#pragma unroll
    for (int i = 0; i < 7; ++i) {
        float r[4]; load_raw4(r, QK, sconv, rel0 - 3 + i, rowbase, col);
#pragma unroll
        for (int tt = 0; tt < 4; ++tt) { const int j = i - tt; if (j >= 0 && j < 4) {
#pragma unroll
            for (int e = 0; e < 4; ++e) acc[tt][e] += w[j][e] * r[e]; } }
    }
#pragma unroll
    for (int i = 0; i < 4; ++i) {
#pragma unroll
        for (int e = 0; e < 4; ++e) acc[i][e] = silu_f(acc[i][e]) * scale;
        out[i].x = pk2(acc[i][0], acc[i][1]); out[i].y = pk2(acc[i][2], acc[i][3]); }
}

__device__ __forceinline__ void phase_conv(const Params& p) {
    int tid = threadIdx.x; asm volatile("" : "+v"(tid));
    unsigned char* ws = p.ws; asm volatile("" : "+s"(ws));
    const bf16_t* QK = (const bf16_t*)(ws + WS_Z + 2 * RSZ); bf16_t* QKC = (bf16_t*)(ws + WS_QKC);
    const int col = 4 * tid; const float sc = col < D ? 1.0f : 0.0625f;
    f32x4 w[4], bias = *(const GAS f32x4*)(p.conv_b + col);
#pragma unroll
    for (int j = 0; j < 4; ++j) w[j] = *(const GAS f32x4*)(p.conv_w + (size_t)j * 2 * D + col);
    for (int rg0 = blockIdx.x; rg0 < NP / 4; rg0 += 2 * gridDim.x) {
        u32x2 raw[2][7]; bool ok[2];
#pragma unroll
        for (int u = 0; u < 2; ++u) { const int rg = rg0 + u * gridDim.x; ok[u] = rg < NP / 4 && (rg & (SEQ / 4 - 1)) != 0; const int R = 4 * (ok[u] ? rg : (rg0 | 1));
#pragma unroll
            for (int i = 0; i < 7; ++i) raw[u][i] = ok[u] ? *(const GAS u32x2*)(QK + (size_t)(R - 3 + i) * (2 * D) + col) : (u32x2){0u, 0u}; }
#pragma unroll
        for (int u = 0; u < 2; ++u) if (ok[u]) { const int R = 4 * (rg0 + u * gridDim.x);
            f32x4 acc[4] = {bias, bias, bias, bias};
#pragma unroll
            for (int i = 0; i < 7; ++i) { const f32x4 r = (f32x4){bflo(raw[u][i].x), bfhi(raw[u][i].x), bflo(raw[u][i].y), bfhi(raw[u][i].y)};
#pragma unroll
                for (int tt = 0; tt < 4; ++tt) { const int j = i - tt; if (j >= 0 && j < 4) acc[tt] += w[j] * r; } }
#pragma unroll
            for (int i = 0; i < 4; ++i) { u32x2 o; o.x = pk2(silu_f(acc[i][0]) * sc, silu_f(acc[i][1]) * sc); o.y = pk2(silu_f(acc[i][2]) * sc, silu_f(acc[i][3]) * sc);
                *(GAS u32x2*)(QKC + (size_t)(R + i) * (2 * D) + col) = o; } }
    }
    for (int k = blockIdx.x; k < NB_P + NS / 4; k += gridDim.x) {
        const int rg = k < NB_P ? k * (SEQ / 4) : NP / 4 + (k - NB_P);
        const int R = 4 * rg; int rel0; size_t rowbase; const float* sconv;
        if (R < NP) { rel0 = R & (SEQ - 1); rowbase = (size_t)(R - rel0); sconv = nullptr; }
        else { rel0 = 0; rowbase = (size_t)R; sconv = p.state_conv + (size_t)((R - NP) >> 2) * 3 * 2 * D; }
        u32x2 o[4]; conv_silu_4x4(o, p, QK, sconv, rel0, rowbase, col, sc);
#pragma unroll
        for (int i = 0; i < 4; ++i) *(GAS u32x2*)(QKC + (size_t)(R + i) * (2 * D) + col) = o[i];
    }
}
__device__ __forceinline__ void phase_gate_scan(const Params& p) {
    int tid = threadIdx.x; asm volatile("" : "+v"(tid));
    const int lane = tid & 63, wid = tid >> 6, gw = blockIdx.x * NWAVES + wid, NGW = gridDim.x * NWAVES;
    const float* G = (const float*)(p.ws + WS_G); f32x4* GP = (f32x4*)(p.ws + WS_GP);
    for (int it = gw; it < (NP / 64) * 4; it += NGW) { const int c = it >> 2, h = it & 3; const size_t row = (size_t)c * 64 + lane;
        const float ic = G[row * 8 + h], fc = G[row * 8 + 4 + h];
        float bc = fc;
#pragma unroll
        for (int o = 1; o < 64; o <<= 1) { const float uu = __shfl_up(bc, o); if (lane >= o) bc += uu; }
        const float a = ic - bc; float pm = a;
#pragma unroll
        for (int o = 1; o < 64; o <<= 1) { const float uu = __shfl_up(pm, o); if (lane >= o) pm = fmaxf(pm, uu); }
        GP[row * 4 + h] = (f32x4){bc, a, pm, pm}; }
}

__device__ __forceinline__ void mlstm_gates_reg(LAS float* GT, f32x4 gp, float m_run, int lane) {
    LAS float* ROWT = GT; LAS float* COLT = GT + 64; LAS float* WINTER = GT + 128; LAS float* WIN = GT + 192; LAS float* DFLOOR = GT + 256; LAS float* MISC = GT + 320;
    const float bc = gp[0], a = gp[1], pm = fmaxf(gp[2], gp[3]);
    const float inter = bc + m_run, mt = fmaxf(inter, bc + pm);
    const float blast = __shfl(bc, 63), amax = __shfl(pm, 63);
    const float mnew = fmaxf(blast + m_run, blast + amax);
    ROWT[lane] = bc - mt; COLT[lane] = a; WINTER[lane] = __expf(inter - mt); WIN[lane] = __expf(blast + a - mnew); DFLOOR[lane] = __expf(-mt);
    if (lane == 0) { MISC[0] = __expf(blast + m_run - mnew); MISC[1] = mnew; }
}

__device__ __forceinline__ void mlstm_prompt_item(const Params& p, LAS unsigned char* lds, int b, int h, int js) {
    constexpr int TT = 4, LV = 64, NCH = 32, KSP = 64, SLD = KSP + 8;
    int tid = threadIdx.x; asm volatile("" : "+v"(tid));
    const int lane = tid & 63, wid = __builtin_amdgcn_readfirstlane(tid >> 6);
    unsigned char* ws = p.ws; asm volatile("" : "+s"(ws));
    const bf16_t* QKC = (const bf16_t*)(ws + WS_QKC); const bf16_t* VM = (const bf16_t*)(ws + WS_Z + 4 * RSZ);
    const GAS f32x4* GP = (const GAS f32x4*)(ws + WS_GP); GAS float* DEN = (GAS float*)(ws + WS_DEN); GAS bf16_t* HM = (GAS bf16_t*)(ws + WS_HM);
    const size_t rowbase = (size_t)b * SEQ;
    const int v0 = js * 64, dbase = wid * 32;
    LAS bf16_t* Qs = (LAS bf16_t*)(lds + OFF_QS); LAS bf16_t* KK = (LAS bf16_t*)(lds + OFF_KK); LAS bf16_t* VT = (LAS bf16_t*)(lds + OFF_VT);
    LAS bf16_t* Ss = (LAS bf16_t*)(lds + OFF_SS); LAS bf16_t* Cs = (LAS bf16_t*)(lds + OFF_CS); LAS float* GT = (LAS float*)(lds + OFF_GT);
    LAS float* ROWT = GT; LAS float* COLT = GT + 64; LAS float* WINTER = GT + 128; LAS float* WIN = GT + 192; LAS float* DFLOOR = GT + 256; LAS float* MISC = GT + 320;

    f32x4 C[5][2];
#pragma unroll
    for (int vi = 0; vi < 5; ++vi)
#pragma unroll
        for (int di = 0; di < 2; ++di) C[vi][di] = (f32x4){0.f, 0.f, 0.f, 0.f};
    float m_run = 0.f;
    __syncthreads();
    for (int i = tid; i < 80 * CS_LD / 2; i += NT) ((LAS unsigned*)Cs)[i] = 0u;
    for (int i = tid; i < 16 * KSP; i += NT) { const int rr = 64 + i / KSP, s = i % KSP; VT[rr * SLD + s] = (rr == 64) ? (bf16_t)0x3F80 : (bf16_t)0; }
    for (int i = tid; i < 64 * SLD / 2; i += NT) ((LAS unsigned*)Ss)[i] = 0u;

    u32x4 qr[4], kr[4], va, vc; f32x4 gpr;
    { const int dg = tid & 31, tp = tid >> 5, vg = tid & 7, sp = (tid >> 3) & 31;
#pragma unroll
      for (int i = 0; i < 4; ++i) { qr[i] = *(const GAS u32x4*)(QKC + (rowbase + 4 * tp + i) * (2 * D) + 256 * h + 8 * dg); kr[i] = *(const GAS u32x4*)(QKC + (rowbase + 4 * tp + i) * (2 * D) + D + 256 * h + 8 * dg); }
      va = *(const GAS u32x4*)(VM + (rowbase + 2 * sp) * D + 256 * h + v0 + 8 * vg); vc = *(const GAS u32x4*)(VM + (rowbase + 2 * sp + 1) * D + 256 * h + v0 + 8 * vg);
      gpr = GP[(rowbase + lane) * 4 + h]; }
    const int ns_t = (wid >= 4) ? 2 : (wid < 2 ? 1 : 0);
    const int sidx0 = (wid >= 4) ? 2 * (wid - 4) : 8 + wid;
    const int nn_t = (wid < 4) ? 3 : 2;

    for (int ch = 0; ch < NCH; ++ch) {
        int lt = tid; asm volatile("" : "+v"(lt));
        const int fr = lt & 15, fq = (lt >> 4) & 3, dg = lt & 31, tp = lt >> 5, vg = lt & 7, sp = (lt >> 3) & 31, ln = lt & 63;
        const size_t r0 = rowbase + (size_t)ch * LV;
        if (wid == 0) mlstm_gates_reg(GT, gpr, m_run, ln);
#pragma unroll
        for (int i = 0; i < 4; ++i) { *(LAS u32x4*)(Qs + (4 * tp + i) * QS_LD + 8 * dg) = qr[i]; *(LAS u32x4*)(KK + (4 * tp + i) * QS_LD + 8 * dg) = kr[i]; }
        if (lt < 256) { const unsigned aw[4] = {va.x, va.y, va.z, va.w}, cw[4] = {vc.x, vc.y, vc.z, vc.w};
#pragma unroll
            for (int e = 0; e < 4; ++e) { *(LAS unsigned*)(VT + (8 * vg + 2 * e) * SLD + 2 * sp) = (aw[e] & 0xffffu) | (cw[e] << 16);
                                          *(LAS unsigned*)(VT + (8 * vg + 2 * e + 1) * SLD + 2 * sp) = (aw[e] >> 16) | (cw[e] & 0xffff0000u); } }
        u32x4 kc[4];
#pragma unroll
        for (int i = 0; i < 4; ++i) kc[i] = kr[i];
        if (ch + 1 < NCH) { const size_t rn = r0 + LV;
            gpr = GP[(rn + ln) * 4 + h];
#pragma unroll
            for (int i = 0; i < 4; ++i) { qr[i] = *(const GAS u32x4*)(QKC + (rn + 4 * tp + i) * (2 * D) + 256 * h + 8 * dg); kr[i] = *(const GAS u32x4*)(QKC + (rn + 4 * tp + i) * (2 * D) + D + 256 * h + 8 * dg); }
            va = *(const GAS u32x4*)(VM + (rn + 2 * sp) * D + 256 * h + v0 + 8 * vg); vc = *(const GAS u32x4*)(VM + (rn + 2 * sp + 1) * D + 256 * h + v0 + 8 * vg);
 }
        LDS_BARRIER();
        for (int j = 0; j < ns_t; ++j) { const int idx = sidx0 + j, ti = idx >= 6 ? 3 : (idx >= 3 ? 2 : (idx >= 1 ? 1 : 0)), si = idx - ti * (ti + 1) / 2;
            f32x4 acc = (f32x4){0.f, 0.f, 0.f, 0.f};
            bf16x8 kfa[8], qfa[8];
#pragma unroll
            for (int kk = 0; kk < 8; ++kk) { kfa[kk] = *(const LAS bf16x8*)(KK + (16 * si + fr) * QS_LD + 32 * kk + 8 * fq); qfa[kk] = *(const LAS bf16x8*)(Qs + (16 * ti + fr) * QS_LD + 32 * kk + 8 * fq); }
            const int t = 16 * ti + fr; const float rt = ROWT[t];
            float ct[4];
#pragma unroll
            for (int r = 0; r < 4; ++r) ct[r] = COLT[16 * si + 4 * fq + r];
            __builtin_amdgcn_s_setprio(1);
#pragma unroll
            for (int kk = 0; kk < 8; ++kk) acc = __builtin_amdgcn_mfma_f32_16x16x32_bf16(kfa[kk], qfa[kk], acc, 0, 0, 0);
            __builtin_amdgcn_s_setprio(0);
            float sv[4];
#pragma unroll
            for (int r = 0; r < 4; ++r) { const int s = 16 * si + 4 * fq + r; sv[r] = (s <= t) ? __expf(rt + ct[r]) * acc[r] : 0.f; }
            u32x2 o; o.x = pk2(sv[0], sv[1]); o.y = pk2(sv[2], sv[3]);
            *(LAS u32x2*)(Ss + t * SLD + 16 * si + 4 * fq) = o; }
        f32x4 nacc[3];
        { const int ti = wid & 3, vb = wid >> 2;
#pragma unroll
          for (int j = 0; j < 3; ++j) nacc[j] = (f32x4){0.f, 0.f, 0.f, 0.f};
          bf16x8 qfa[8];
#pragma unroll
          for (int kk = 0; kk < 8; ++kk) qfa[kk] = *(const LAS bf16x8*)(Qs + (16 * ti + fr) * QS_LD + 32 * kk + 8 * fq);
#pragma unroll
          for (int j = 0; j < 3; ++j) if (j < nn_t) { bf16x8 cfa[8];
#pragma unroll
              for (int kk = 0; kk < 8; ++kk) cfa[kk] = *(const LAS bf16x8*)(Cs + (16 * (vb + 2 * j) + fr) * CS_LD + 32 * kk + 8 * fq);
              __builtin_amdgcn_s_setprio(1);
#pragma unroll
              for (int kk = 0; kk < 8; ++kk) nacc[j] = __builtin_amdgcn_mfma_f32_16x16x32_bf16(cfa[kk], qfa[kk], nacc[j], 0, 0, 0);
              __builtin_amdgcn_s_setprio(0); }
          const float wi = WINTER[16 * ti + fr];
#pragma unroll
          for (int j = 0; j < 3; ++j) nacc[j] = nacc[j] * wi; }
        LDS_BARRIER();
        { const float w0 = WIN[4 * tp], w1 = WIN[4 * tp + 1], w2 = WIN[4 * tp + 2], w3 = WIN[4 * tp + 3];
          const unsigned k0w[4] = {kc[0].x, kc[0].y, kc[0].z, kc[0].w}, k1w[4] = {kc[1].x, kc[1].y, kc[1].z, kc[1].w}, k2w[4] = {kc[2].x, kc[2].y, kc[2].z, kc[2].w}, k3w[4] = {kc[3].x, kc[3].y, kc[3].z, kc[3].w};
#pragma unroll
          for (int e = 0; e < 4; ++e) {
              u32x2 lo, hi; lo.x = pk2(w0 * bflo(k0w[e]), w1 * bflo(k1w[e])); lo.y = pk2(w2 * bflo(k2w[e]), w3 * bflo(k3w[e]));
              hi.x = pk2(w0 * bfhi(k0w[e]), w1 * bfhi(k1w[e])); hi.y = pk2(w2 * bfhi(k2w[e]), w3 * bfhi(k3w[e]));
              const int pc = ((((tp >> 1) + (dg >> 1)) & 7) << 3) + ((tp & 1) << 2);
              *(LAS u32x2*)(KK + (8 * dg + 2 * e) * SLD + pc) = lo; *(LAS u32x2*)(KK + (8 * dg + 2 * e + 1) * SLD + pc) = hi; } }
        bf16x8 sfa[2], vfa[3][2];
#pragma unroll
        for (int kk = 0; kk < 2; ++kk) { sfa[kk] = *(const LAS bf16x8*)(Ss + (16 * (wid & 3) + fr) * SLD + 32 * kk + 8 * fq);
#pragma unroll
            for (int j = 0; j < 3; ++j) vfa[j][kk] = *(const LAS bf16x8*)(VT + (16 * ((wid >> 2) + 2 * (j < nn_t ? j : 0)) + fr) * SLD + 32 * kk + 8 * fq); }
#pragma unroll
        for (int j = 0; j < 3; ++j) if (j < nn_t) { const int ti = wid & 3, vi = (wid >> 2) + 2 * j;
            f32x4 acc = nacc[j];
#pragma unroll
            for (int kk = 0; kk < 2; ++kk) acc = __builtin_amdgcn_mfma_f32_16x16x32_bf16(vfa[j][kk], sfa[kk], acc, 0, 0, 0);
            const int t = 16 * ti + fr;
            if (vi < 4) { u32x2 o; o.x = pk2(acc[0], acc[1]); o.y = pk2(acc[2], acc[3]); *(GAS u32x2*)(HM + (r0 + t) * D + 256 * h + v0 + 16 * vi + 4 * fq) = o; }
            else if (js == 0 && fq == 0) DEN[(r0 + t) * 4 + h] = fmaxf(fabsf(acc[0]), DFLOOR[t]); }
        LDS_BARRIER();
        { const float decay = MISC[0];
          bf16x8 ktf[2][2], vtf[2][5];
#pragma unroll
          for (int kk = 0; kk < 2; ++kk) {
#pragma unroll
              for (int di = 0; di < 2; ++di) ktf[kk][di] = *(const LAS bf16x8*)(KK + (dbase + 16 * di + fr) * SLD + (((4 * kk + fq + 2 * wid + di) & 7) << 3));
#pragma unroll
              for (int vi = 0; vi < 5; ++vi) vtf[kk][vi] = *(const LAS bf16x8*)(VT + (16 * vi + fr) * SLD + 32 * kk + 8 * fq); }
#pragma unroll
          for (int vi = 0; vi < 5; ++vi)
#pragma unroll
              for (int di = 0; di < 2; ++di) C[vi][di] = C[vi][di] * decay;
          __builtin_amdgcn_s_setprio(1);
#pragma unroll
          for (int kk = 0; kk < 2; ++kk)
#pragma unroll
              for (int vi = 0; vi < 5; ++vi)
#pragma unroll
                  for (int di = 0; di < 2; ++di) C[vi][di] = __builtin_amdgcn_mfma_f32_16x16x32_bf16(ktf[kk][di], vtf[kk][vi], C[vi][di], 0, 0, 0);
          __builtin_amdgcn_s_setprio(0);
          if (ch + 1 < NCH) {
#pragma unroll
              for (int vi = 0; vi < 5; ++vi)
#pragma unroll
                  for (int di = 0; di < 2; ++di) { u32x2 o; o.x = pk2(C[vi][di][0], C[vi][di][1]); o.y = pk2(C[vi][di][2], C[vi][di][3]);
                      *(LAS u32x2*)(Cs + (16 * vi + fr) * CS_LD + dbase + 16 * di + 4 * fq) = o; } }
          m_run = MISC[1]; }
        LDS_BARRIER();
    }
    { const int fr = lane & 15, fq = lane >> 4;
      float* Co = p.out + O_CP; float* no = p.out + O_NP; float* mo = p.out + O_MP;
#pragma unroll
      for (int vi = 0; vi < 4; ++vi)
#pragma unroll
          for (int di = 0; di < 2; ++di) *(GAS f32x4*)(Co + ((size_t)(b * 4 + h) * 256 + v0 + 16 * vi + fr) * 256 + dbase + 16 * di + 4 * fq) = C[vi][di];
      if (js == 0) {
          if (fr == 0) {
#pragma unroll
              for (int di = 0; di < 2; ++di) *(GAS f32x4*)(no + (size_t)(b * 4 + h) * 256 + dbase + 16 * di + 4 * fq) = C[4][di]; }
          if (tid == 0) mo[b * 4 + h] = m_run; } }
}

__device__ __forceinline__ void mlstm_sample_valu(const Params& p, int b, int h) {
    int tid = threadIdx.x; asm volatile("" : "+v"(tid));
    const int lane = tid & 63, wid = __builtin_amdgcn_readfirstlane(tid >> 6);
    unsigned char* ws = p.ws; asm volatile("" : "+s"(ws));
    const GAS bf16_t* QKC = (const GAS bf16_t*)(ws + WS_QKC); const GAS bf16_t* VM = (const GAS bf16_t*)(ws + WS_Z + 4 * RSZ);
    const GAS float* G = (const GAS float*)(ws + WS_G); GAS float* DEN = (GAS float*)(ws + WS_DEN); GAS bf16_t* HM = (GAS bf16_t*)(ws + WS_HM);
    const size_t r0 = (size_t)NP + (size_t)b * TS;
    const GAS float* C0 = (const GAS float*)p.state_C + (size_t)(b * 4 + h) * 65536; GAS float* Co = (GAS float*)p.out + O_CS + (size_t)(b * 4 + h) * 65536;
    const int vbase = wid * 32;
    f32x4 cpre[8];
#pragma unroll
    for (int i = 0; i < 8; ++i) cpre[i] = __builtin_nontemporal_load((const GAS f32x4*)(C0 + (size_t)(vbase + i) * 256 + 4 * lane));
    float q[4][4], k[4][4], vreg[4], ic[4], fc[4];
#pragma unroll
    for (int t = 0; t < 4; ++t) { const u32x2 wq = *(const GAS u32x2*)(QKC + (r0 + t) * (2 * D) + 256 * h + 4 * lane), wk = *(const GAS u32x2*)(QKC + (r0 + t) * (2 * D) + D + 256 * h + 4 * lane);
        q[t][0] = bflo(wq.x); q[t][1] = bfhi(wq.x); q[t][2] = bflo(wq.y); q[t][3] = bfhi(wq.y); k[t][0] = bflo(wk.x); k[t][1] = bfhi(wk.x); k[t][2] = bflo(wk.y); k[t][3] = bfhi(wk.y);
        const bf16_t vv = VM[(r0 + t) * D + 256 * h + vbase + (lane & 31)]; vreg[t] = __uint_as_float((unsigned)vv << 16);
        ic[t] = G[(r0 + t) * 8 + h]; fc[t] = G[(r0 + t) * 8 + 4 + h]; }
    const float m0 = p.state_m[b * 4 + h];
    float bc[4], a[4], pm[4], mt[4], winter[4], win[4];
    bc[0] = fc[0]; bc[1] = bc[0] + fc[1]; bc[2] = bc[1] + fc[2]; bc[3] = bc[2] + fc[3];
#pragma unroll
    for (int t = 0; t < 4; ++t) a[t] = ic[t] - bc[t];
    pm[0] = a[0]; pm[1] = fmaxf(pm[0], a[1]); pm[2] = fmaxf(pm[1], a[2]); pm[3] = fmaxf(pm[2], a[3]);
#pragma unroll
    for (int t = 0; t < 4; ++t) { const float inter = bc[t] + m0; mt[t] = fmaxf(inter, bc[t] + pm[t]); winter[t] = __expf(inter - mt[t]); }
    const float blast = bc[3], mnew = fmaxf(blast + m0, blast + pm[3]), decay = __expf(blast + m0 - mnew);
#pragma unroll
    for (int s = 0; s < 4; ++s) win[s] = __expf(blast + a[s] - mnew);
    const int tl = lane >> 4;
    float wt = winter[0], rtl = bc[0] - mt[0], St[4];
#pragma unroll
    for (int t = 1; t < 4; ++t) if (tl == t) { wt = winter[t]; rtl = bc[t] - mt[t]; }
#pragma unroll
    for (int s = 0; s < 4; ++s) { float d0 = 0.f, d1 = 0.f, d2 = 0.f, d3 = 0.f;
#pragma unroll
        for (int e = 0; e < 4; ++e) { d0 += q[0][e] * k[s][e]; d1 += q[1][e] * k[s][e]; d2 += q[2][e] * k[s][e]; d3 += q[3][e] * k[s][e]; }
        d0 = wave_sum(d0); d1 = wave_sum(d1); d2 = wave_sum(d2); d3 = wave_sum(d3);
        const float dd = tl == 0 ? d0 : (tl == 1 ? d1 : (tl == 2 ? d2 : d3));
        St[s] = (s <= tl) ? __expf(rtl + a[s]) * dd : 0.f; }
#define RED4(p0, p1, p2, p3, out) do { const bool _hi = lane >= 32; \
        const float _s0 = (_hi ? p2 : p0) + __shfl_xor(_hi ? p0 : p2, 32), _s1 = (_hi ? p3 : p1) + __shfl_xor(_hi ? p1 : p3, 32); \
        const bool _h2 = (lane & 16) != 0; float _u = (_h2 ? _s1 : _s0) + __shfl_xor(_h2 ? _s0 : _s1, 16); \
        _u += __shfl_xor(_u, 8); _u += __shfl_xor(_u, 4); _u += __shfl_xor(_u, 2); _u += __shfl_xor(_u, 1); out = _u; } while (0)
    float R0 = 0.f, R1 = 0.f;
    for (int i0 = 0; i0 < 32; i0 += 8) {
        f32x4 c[8];
#pragma unroll
        for (int i = 0; i < 8; ++i) c[i] = cpre[i];
        if (i0 + 8 < 32) {
#pragma unroll
            for (int i = 0; i < 8; ++i) cpre[i] = __builtin_nontemporal_load((const GAS f32x4*)(C0 + (size_t)(vbase + i0 + 8 + i) * 256 + 4 * lane)); }
#pragma unroll
        for (int i = 0; i < 8; ++i) { const int row = i0 + i;
            float vs[4];
#pragma unroll
            for (int s = 0; s < 4; ++s) vs[s] = __shfl(vreg[s], row);
            float p0 = 0.f, p1 = 0.f, p2 = 0.f, p3 = 0.f; f32x4 cn;
#pragma unroll
            for (int e = 0; e < 4; ++e) { p0 += c[i][e] * q[0][e]; p1 += c[i][e] * q[1][e]; p2 += c[i][e] * q[2][e]; p3 += c[i][e] * q[3][e];
                cn[e] = decay * c[i][e] + ((win[0] * vs[0]) * k[0][e] + (win[1] * vs[1]) * k[1][e]) + ((win[2] * vs[2]) * k[2][e] + (win[3] * vs[3]) * k[3][e]); }
            __builtin_nontemporal_store(cn, (GAS f32x4*)(Co + (size_t)(vbase + row) * 256 + 4 * lane));
            float tot; RED4(p0, p1, p2, p3, tot);
            const float nv = wt * tot + ((St[0] * vs[0] + St[1] * vs[1]) + (St[2] * vs[2] + St[3] * vs[3]));
            if ((lane & 15) == (row & 15)) { if (row < 16) R0 = nv; else R1 = nv; } }
    }
    { const int j = lane & 15;
      GAS bf16_t* hp = HM + (r0 + tl) * D + 256 * h + vbase + j;
      hp[0] = (bf16_t)(pk2(R0, 0.f) & 0xffffu); hp[16] = (bf16_t)(pk2(R1, 0.f) & 0xffffu); }
    if (wid == 0) {
        const f32x4 nrow = *(const GAS f32x4*)(p.state_n + (size_t)(b * 4 + h) * 256 + 4 * lane);
        float p0 = 0.f, p1 = 0.f, p2 = 0.f, p3 = 0.f; f32x4 nn;
#pragma unroll
        for (int e = 0; e < 4; ++e) { p0 += nrow[e] * q[0][e]; p1 += nrow[e] * q[1][e]; p2 += nrow[e] * q[2][e]; p3 += nrow[e] * q[3][e];
            nn[e] = decay * nrow[e] + (win[0] * k[0][e] + win[1] * k[1][e]) + (win[2] * k[2][e] + win[3] * k[3][e]); }
        *(GAS f32x4*)(p.out + O_NS + (size_t)(b * 4 + h) * 256 + 4 * lane) = nn;
        float tot; RED4(p0, p1, p2, p3, tot);
        const float den = wt * tot + ((St[0] + St[1]) + (St[2] + St[3]));
        float mtl = mt[0];
#pragma unroll
        for (int t = 1; t < 4; ++t) if (tl == t) mtl = mt[t];
        if ((lane & 15) == 0) DEN[(r0 + tl) * 4 + h] = fmaxf(fabsf(den), __expf(-mtl));
        if (lane == 0) p.out[O_MS + b * 4 + h] = mnew;
    }
#undef RED4
}

__device__ __forceinline__ void gmlp_prompt_item(const Params& p, LAS unsigned char* lds, int item) {
    int tid = threadIdx.x; asm volatile("" : "+v"(tid));
    const int lane = tid & 63, wid = __builtin_amdgcn_readfirstlane(tid >> 6), fr = lane & 15, fq = lane >> 4;
    unsigned char* ws = p.ws; asm volatile("" : "+s"(ws));
    const bf16_t* U = (const bf16_t*)(ws + WS_Z); const bf16_t* GV = (const bf16_t*)(ws + WS_Z + RSZ); bf16_t* AOUT = (bf16_t*)(ws + WS_AOUT);
    const bf16_t* WSB = (const bf16_t*)(ws + WS_WSB);
    const size_t r0 = (size_t)item * 128;
    constexpr int VLD = 136;
    LAS bf16_t* VT = (LAS bf16_t*)lds;
    LAS float* MEAN = (LAS float*)(lds + 69632); LAS float* RSTD = MEAN + 128;
    __syncthreads();
#pragma unroll
    for (int grp = 0; grp < 4; ++grp) { const int row = wid * 16 + grp * 4 + fq; float s = 0.f, ss = 0.f;
#pragma unroll
        for (int i = 0; i < 8; ++i) { const u32x4 w = *(const GAS u32x4*)(GV + (r0 + row) * D + (i * 16 + fr) * 8);
            const unsigned ww[4] = {w.x, w.y, w.z, w.w};
#pragma unroll
            for (int e = 0; e < 4; ++e) { const f32x2 gg = gelu_pk((f32x2){bflo(ww[e]), bfhi(ww[e])}); const float a = gg.x, c = gg.y; s += a + c; ss += a * a + c * c; } }
#pragma unroll
        for (int o = 1; o < 16; o <<= 1) { s += __shfl_xor(s, o); ss += __shfl_xor(ss, o); }
        if (fr == 0) { const float mu = s * (1.0f / D); MEAN[row] = mu; RSTD[row] = rsqrtf(fmaxf(ss * (1.0f / D) - mu * mu, 0.f) + EPS); } }
    __syncthreads();
    const int nks = (16 * wid + 15) / 32 + 1;
    for (int g = 0; g < 4; ++g) {
        { const int s = 2 * lane; const int cb = 256 * g + 32 * wid;
          const float mu0 = MEAN[s], rs0 = RSTD[s], mu1 = MEAN[s + 1], rs1 = RSTD[s + 1];
#pragma unroll
          for (int i = 0; i < 4; ++i) { const u32x4 a = *(const GAS u32x4*)(GV + (r0 + s) * D + cb + 8 * i), c = *(const GAS u32x4*)(GV + (r0 + s + 1) * D + cb + 8 * i);
              const unsigned aw[4] = {a.x, a.y, a.z, a.w}, cw[4] = {c.x, c.y, c.z, c.w};
#pragma unroll
              for (int e = 0; e < 4; ++e) { const int c0 = cb + 8 * i + 2 * e; const float g0 = p.ln_g[c0], g1 = p.ln_g[c0 + 1], b0 = p.ln_b[c0], b1 = p.ln_b[c0 + 1];
                  const f32x2 ya = gelu_pk((f32x2){bflo(aw[e]), bfhi(aw[e])}), yc = gelu_pk((f32x2){bflo(cw[e]), bfhi(cw[e])});
                  const float x00 = (ya.x - mu0) * rs0 * g0 + b0, x01 = (ya.y - mu0) * rs0 * g1 + b1;
                  const float x10 = (yc.x - mu1) * rs1 * g0 + b0, x11 = (yc.y - mu1) * rs1 * g1 + b1;
                  *(LAS unsigned*)(VT + (32 * wid + 8 * i + 2 * e) * VLD + s) = pk2(x00, x10);
                  *(LAS unsigned*)(VT + (32 * wid + 8 * i + 2 * e + 1) * VLD + s) = pk2(x01, x11); } } }
        bf16x8 af[4];
#pragma unroll
        for (int ks = 0; ks < 4; ++ks) af[ks] = (ks < nks) ? *(const GAS bf16x8*)(WSB + ((size_t)(g * 128 + 16 * wid + fr)) * 128 + 32 * ks + 8 * fq) : (bf16x8){0, 0, 0, 0, 0, 0, 0, 0};
        const int t = 16 * wid + fr; const float bs = p.b_s[g * 128 + t];
        u32x2 uu16[16];
#pragma unroll
        for (int ci = 0; ci < 16; ++ci) uu16[ci] = *(const GAS u32x2*)(U + (r0 + t) * D + 256 * g + 16 * ci + 4 * fq);
        __syncthreads();
#pragma unroll
        for (int ci = 0; ci < 16; ++ci) {
            f32x4 acc = (f32x4){0.f, 0.f, 0.f, 0.f};
#pragma unroll
            for (int ks = 0; ks < 4; ++ks) if (ks < nks) { const bf16x8 vf = *(const LAS bf16x8*)(VT + (16 * ci + fr) * VLD + 32 * ks + 8 * fq);
                acc = __builtin_amdgcn_mfma_f32_16x16x32_bf16(vf, af[ks], acc, 0, 0, 0); }
            const size_t off = (r0 + t) * D + 256 * g + 16 * ci + 4 * fq;
            const u32x2 uu = uu16[ci];
            const f32x2 ga = gelu_pk((f32x2){bflo(uu.x), bfhi(uu.x)}), gb = gelu_pk((f32x2){bflo(uu.y), bfhi(uu.y)});
            u32x2 o; o.x = pk2(ga.x * (acc[0] + bs), ga.y * (acc[1] + bs)); o.y = pk2(gb.x * (acc[2] + bs), gb.y * (acc[3] + bs));
            *(GAS u32x2*)(AOUT + off) = o; }
        __syncthreads();
    }
}

__device__ __forceinline__ void gmlp_sample_item(const Params& p, LAS unsigned char* lds, int b) {
    int tid = threadIdx.x; asm volatile("" : "+v"(tid));
    const int lane = tid & 63, wid = tid >> 6;
    unsigned char* ws = p.ws;
    const bf16_t* U = (const bf16_t*)(ws + WS_Z); const bf16_t* GV = (const bf16_t*)(ws + WS_Z + RSZ); bf16_t* AOUT = (bf16_t*)(ws + WS_AOUT);
    const size_t r0 = (size_t)NP + (size_t)b * TS;
    LAS float* ST = (LAS float*)lds;
    __syncthreads();
    if (wid < 4) { float s = 0.f, ss = 0.f;
#pragma unroll
        for (int i = 0; i < 2; ++i) { const u32x4 w = *(const GAS u32x4*)(GV + (r0 + wid) * D + (i * 64 + lane) * 8); const unsigned ww[4] = {w.x, w.y, w.z, w.w};
#pragma unroll
            for (int e = 0; e < 4; ++e) { const f32x2 gg = gelu_pk((f32x2){bflo(ww[e]), bfhi(ww[e])}); const float a = gg.x, c = gg.y; s += a + c; ss += a * a + c * c; } }
        s = wave_sum(s); ss = wave_sum(ss);
        if (lane == 0) { const float mu = s * (1.0f / D); ST[wid] = mu; ST[4 + wid] = rsqrtf(fmaxf(ss * (1.0f / D) - mu * mu, 0.f) + EPS); } }
    __syncthreads();
    const int c0 = 2 * tid, g = c0 >> 8;
    float vn[4][2];
    const float lg0 = p.ln_g[c0], lg1 = p.ln_g[c0 + 1], lb0 = p.ln_b[c0], lb1 = p.ln_b[c0 + 1];
#pragma unroll
    for (int s = 0; s < 4; ++s) { const unsigned w = *(const GAS unsigned*)(GV + (r0 + s) * D + c0); const float mu = ST[s], rs = ST[4 + s];
        const f32x2 gy = gelu_pk((f32x2){bflo(w), bfhi(w)});
        vn[s][0] = (gy.x - mu) * rs * lg0 + lb0; vn[s][1] = (gy.y - mu) * rs * lg1 + lb1;
        *(GAS f32x2*)(p.out + O_GMV + ((size_t)b * TS + s) * D + c0) = (f32x2){vn[s][0], vn[s][1]}; }
#pragma unroll
    for (int t = 0; t < 4; ++t) { float s0 = p.b_s[g * 128 + t], s1 = s0;
#pragma unroll
        for (int s = 0; s < 4; ++s) if (s <= t) { const float w = p.w_s[(size_t)(g * 128 + t) * 128 + s]; s0 += w * vn[s][0]; s1 += w * vn[s][1]; }
        const unsigned uu = *(const GAS unsigned*)(U + (r0 + t) * D + c0);
        const f32x2 gu = gelu_pk((f32x2){bflo(uu), bfhi(uu)});
        *(GAS unsigned*)(AOUT + (r0 + t) * D + c0) = pk2(gu.x * s0, gu.y * s1); }
}

__device__ __forceinline__ void conv_state_item(const Params& p, int seq) {
    const bf16_t* QK = (const bf16_t*)(p.ws + WS_Z + 2 * RSZ);
    const bool sample = seq >= NB_P; const int b = sample ? seq - NB_P : seq;
    const size_t rsrc = sample ? (size_t)NP + (size_t)b * TS + 1 : (size_t)b * SEQ + (SEQ - 3);
    float* dst = p.out + (sample ? O_CONVS : O_CONVP) + (size_t)b * 3 * 2 * D;
    int tid = threadIdx.x; asm volatile("" : "+v"(tid));
    for (int i = tid; i < 3 * 2 * D / 2; i += NT) { const unsigned w = ((const unsigned*)(QK + rsrc * 2 * D))[i]; *(GAS f32x2*)(dst + 2 * i) = (f32x2){bflo(w), bfhi(w)}; }
}

constexpr int LW_P = 16 * 32, LW_F1 = 16 * 176, LW_F2 = 44 * 32, LW_ALL = 3 * LW_P + LW_F1 + LW_F2, LW_ITEMS = LW_ALL / 8;
__device__ __forceinline__ void late_weight_item(const Params& p, LAS unsigned char* lds, int item) {
    int tid = threadIdx.x; asm volatile("" : "+v"(tid));
    const int lane = tid & 63, wid = tid >> 6;
    unsigned char* ws = p.ws; asm volatile("" : "+s"(ws));
    LAS float* scr = (LAS float*)(lds + wid * 8448);
    __syncthreads();
    int r = item * 8 + wid;
    if (r < LW_P) { transpose_item(p.w_proj_a, D, D, (bf16_t*)(ws + WS_WPA), (r / 32) * 64, (r % 32) * 32, (r % 32) * 32, scr, lane); return; } r -= LW_P;
    if (r < LW_P) { transpose_item(p.w_proj_b, D, D, (bf16_t*)(ws + WS_WPB), (r / 32) * 64, (r % 32) * 32, (r % 32) * 32, scr, lane); return; } r -= LW_P;
    if (r < LW_P) { transpose_item(p.w_out, D, D, (bf16_t*)(ws + WS_WO), (r / 32) * 64, (r % 32) * 32, (r % 32) * 32, scr, lane); return; } r -= LW_P;
    if (r < LW_F1) { const int kb = r / 176, nb = r % 176, n0 = nb * 32, pn = n0 >> 8, within = n0 & 255, half = within >> 7, jj0 = within & 127;
        transpose_item(p.w_ffn_in, 2 * DFF, D, (bf16_t*)(ws + WS_WF1), kb * 64, half * DFF + 128 * pn + jj0, n0, scr, lane); return; } r -= LW_F1;
    transpose_item(p.w_ffn_out, D, DFF, (bf16_t*)(ws + WS_WF2), (r / 32) * 64, (r % 32) * 32, (r % 32) * 32, scr, lane);
}

__device__ __forceinline__ void phase_bout(const Params& p) {
    int tid = threadIdx.x; asm volatile("" : "+v"(tid));
    const int lane = tid & 63, wid = tid >> 6, gw = blockIdx.x * NWAVES + wid, NGW = gridDim.x * NWAVES;
    const GAS bf16_t* HM = (const GAS bf16_t*)(p.ws + WS_HM); const GAS bf16_t* SO = (const GAS bf16_t*)(p.ws + WS_Z + 5 * RSZ); const GAS float* DEN = (const GAS float*)(p.ws + WS_DEN);
    GAS bf16_t* BOUT = (GAS bf16_t*)(p.ws + WS_BOUT);
    f32x4 g4[4];
#pragma unroll
    for (int hh = 0; hh < 4; ++hh) g4[hh] = *(const GAS f32x4*)(p.hn_g + 256 * hh + 4 * lane);
    for (int row0 = gw; row0 < MT; row0 += 2 * NGW) {
        u32x2 w[2][4], so[2][4]; f32x4 dn[2];
#pragma unroll
        for (int rr = 0; rr < 2; ++rr) { const int row = (row0 + rr * NGW < MT) ? row0 + rr * NGW : row0;
            dn[rr] = *(const GAS f32x4*)(DEN + (size_t)row * 4);
#pragma unroll
            for (int hh = 0; hh < 4; ++hh) { const size_t off = (size_t)row * D + 256 * hh + 4 * lane; w[rr][hh] = *(const GAS u32x2*)(HM + off); so[rr][hh] = *(const GAS u32x2*)(SO + off); } }
#pragma unroll
        for (int rr = 0; rr < 2; ++rr) { const int row = row0 + rr * NGW; if (row < MT) {
#pragma unroll
            for (int hh = 0; hh < 4; ++hh) {
                const size_t off = (size_t)row * D + 256 * hh + 4 * lane; const float inv = 1.0f / dn[rr][hh];
                float x[4] = {bflo(w[rr][hh].x) * inv, bfhi(w[rr][hh].x) * inv, bflo(w[rr][hh].y) * inv, bfhi(w[rr][hh].y) * inv};
                const float mu = wave_sum((x[0] + x[1]) + (x[2] + x[3])) * (1.0f / 256.f);
                float q = 0.f;
#pragma unroll
                for (int e = 0; e < 4; ++e) { x[e] -= mu; q += x[e] * x[e]; }
                const float rs = rsqrtf(wave_sum(q) * (1.0f / 256.f) + EPS);
                u32x2 o; o.x = pk2(sigmoid_f(bflo(so[rr][hh].x)) * x[0] * rs * g4[hh][0], sigmoid_f(bfhi(so[rr][hh].x)) * x[1] * rs * g4[hh][1]); o.y = pk2(sigmoid_f(bflo(so[rr][hh].y)) * x[2] * rs * g4[hh][2], sigmoid_f(bfhi(so[rr][hh].y)) * x[3] * rs * g4[hh][3]);
                *(GAS u32x2*)(BOUT + off) = o; } } }
    }
}
template <bool TO_BF16>
__device__ __forceinline__ void phase_rms(const Params& p, const float* gain, bf16_t* dst, int rbeg = 0) {
    int tid = threadIdx.x; asm volatile("" : "+v"(tid));
    const int lane = tid & 63, wid = tid >> 6, gw = blockIdx.x * NWAVES + wid, NGW = gridDim.x * NWAVES;
    const GAS bf16_t* XB = (const GAS bf16_t*)(p.ws + WS_BOUT); GAS float* Y = (GAS float*)p.out + O_Y;
    f32x4 g4[4];
#pragma unroll
    for (int j = 0; j < 4; ++j) g4[j] = ((const GAS f32x4*)gain)[lane + 64 * j];
    for (int row0 = rbeg + gw; row0 < MT; row0 += 4 * NGW) {
        u32x2 v[4][4];
#pragma unroll
        for (int rr = 0; rr < 4; ++rr) { const int row = (row0 + rr * NGW < MT) ? row0 + rr * NGW : row0;
#pragma unroll
            for (int j = 0; j < 4; ++j) v[rr][j] = ((const GAS u32x2*)(XB + (size_t)row * D))[lane + 64 * j]; }
#pragma unroll
        for (int rr = 0; rr < 4; ++rr) { const int row = row0 + rr * NGW; if (row < MT) {
            f32x4 x[4]; float ss = 0.f;
#pragma unroll
            for (int j = 0; j < 4; ++j) { x[j] = (f32x4){bflo(v[rr][j].x), bfhi(v[rr][j].x), bflo(v[rr][j].y), bfhi(v[rr][j].y)}; ss += (x[j][0] * x[j][0] + x[j][1] * x[j][1]) + (x[j][2] * x[j][2] + x[j][3] * x[j][3]); }
            const float r = rsqrtf(wave_sum(ss) * (1.0f / D) + EPS);
#pragma unroll
            for (int j = 0; j < 4; ++j) { const f32x4 o4 = x[j] * r * g4[j];
                if (TO_BF16) { u32x2 o; o.x = pk2(o4[0], o4[1]); o.y = pk2(o4[2], o4[3]); ((GAS u32x2*)((GAS bf16_t*)dst + (size_t)row * D))[lane + 64 * j] = o; }
                else ((GAS f32x4*)(Y + (size_t)row * D))[lane + 64 * j] = o4; } } }
    }
}

#ifndef PHMASK
#define PHMASK 0xFFFF
#endif
__global__ void __launch_bounds__(NT) fwd_megakernel(Params p) {
    extern __shared__ __attribute__((aligned(16))) unsigned char lds_raw[];
    LAS unsigned char* lds = (LAS unsigned char*)lds_raw;
    unsigned char* ws = p.ws;
    const int G = gridDim.x, bid = blockIdx.x;
    const int tid = threadIdx.x, lane = tid & 63, wid = __builtin_amdgcn_readfirstlane(tid >> 6), fr = lane & 15, fq = lane >> 4;
    volatile LAS unsigned* xst = (volatile LAS unsigned*)(lds + LDS_BYTES - 32);
    if (tid == 0) { xst[0] = 0u; xst[1] = 0u; }
    __syncthreads();
    const XcdBarrier bar = xcd_barrier_post((unsigned*)(ws + WS_CTL), xst);
#define GRID_BAR() xcd_barrier(bar)

#if PHMASK & 1
    phase0(p, lds);
#endif
    GRID_BAR();
#if PHMASK & 2
    { pg8::Gemm g{(const bf16_t*)(ws + WS_H), (const bf16_t*)(ws + WS_WZ), MT, NZ, D}; pg8::StaticOrder S; S.init(MT, NZ, G, bid);
      EpiZ E{(bf16_t*)(ws + WS_Z), p.b_gate}; pg8::gemm_phase(lds, g, S, E); }
    { constexpr int NU = (MT / 256) * (NZ / 256); const int extra = NU % G;
      if (bid >= extra) for (int it = bid - extra; it < LW_ITEMS; it += G - extra) late_weight_item(p, lds, it); }
#endif
    GRID_BAR();
#if PHMASK & 1024
    phase_conv(p);
    phase_gate_scan(p);
    for (int it = bid; it < NB_P + NB_S; it += G) conv_state_item(p, it);
#endif
    GRID_BAR();
#if PHMASK & 4
#ifndef REP2
#define REP2 1
#endif
    for (int rep = 0; rep < REP2; ++rep) {
      for (int it = bid; it < 128; it += G) { const int xcd = it & 7, k = it >> 3, bh = xcd * 4 + (k >> 2);
          mlstm_prompt_item(p, lds, bh >> 2, bh & 3, k & 3); }
      unsigned* qctr = (unsigned*)(ws + WS_CTL) + 16 * rep;
      LAS int* qslot = (LAS int*)(lds + LDS_BYTES - 16);
      constexpr int N_A = 128, N_B = 512, N_C = 128, N_ALL = N_A + N_B + N_C;
      int nxt = 0;
      if (threadIdx.x == 0) nxt = (int)atomicAdd(qctr, 1u);
      for (;;) {
          __syncthreads();
          if (threadIdx.x == 0) *qslot = nxt;
          __syncthreads();
          int it = *qslot;
          if (it >= N_ALL) break;
          if (threadIdx.x == 0) nxt = (int)atomicAdd(qctr, 1u);
          if (it < N_A) { gmlp_prompt_item(p, lds, it); continue; }
          it -= N_A;
          if (it < N_B) { mlstm_sample_valu(p, it >> 2, it & 3); continue; }
          it -= N_B;
          gmlp_sample_item(p, lds, it);
      } }
#endif
    GRID_BAR();
#if PHMASK & 8
    { pg8::StaticOrder S; S.init(NP, D, G, bid);
      pg8::Gemm g{(const bf16_t*)(ws + WS_AOUT), (const bf16_t*)(ws + WS_WPA), NP, D, D}; EpiT1 E{(bf16_t*)(ws + WS_Z), (const bf16_t*)(ws + WS_Z + 6 * RSZ)};
      if (bid & 1) { pg8::gemm_phase(lds, g, S, E); phase_bout(p); }
      else { phase_bout(p); pg8::gemm_phase(lds, g, S, E); } }
#endif
    GRID_BAR();
#if PHMASK & 16
    { pg8::StaticOrder S; S.init(NP, D, G, bid);
      { pg8::Gemm g{(const bf16_t*)(ws + WS_BOUT), (const bf16_t*)(ws + WS_WPB), NP, D, D}; EpiT2 E{(const bf16_t*)(ws + WS_Z), (const bf16_t*)(ws + WS_Z + 7 * RSZ), (bf16_t*)(ws + WS_H)}; pg8::gemm_phase(lds, g, S, E); }
      for (int tl = bid; tl < 256; tl += G) { const int r0 = NP + (tl >> 5) * 64, c0 = (tl & 31) * 32;
          f32x4 acc[4][2]; ZERO_ACC42(acc);
          small_tile_mma<D>((const bf16_t*)(ws + WS_AOUT), (const bf16_t*)(ws + WS_WPA), r0, c0, wid, fr, fq, acc);
          const f32x4 pa = small_tile_reduce(lds, acc, wid, fr, fq);
          ZERO_ACC42(acc);
          small_tile_mma<D>((const bf16_t*)(ws + WS_BOUT), (const bf16_t*)(ws + WS_WPB), r0, c0, wid, fr, fq, acc);
          const f32x4 pb = small_tile_reduce(lds, acc, wid, fr, fq);
          const size_t off = (size_t)(r0 + (tid >> 3)) * D + c0 + 4 * (tid & 7);
          const u32x2 ga = *(const GAS u32x2*)((const bf16_t*)(ws + WS_Z + 6 * RSZ) + off), gb = *(const GAS u32x2*)((const bf16_t*)(ws + WS_Z + 7 * RSZ) + off);
          u32x2 o; o.x = pk2(bflo(ga.x) * pa[0] + bflo(gb.x) * pb[0], bfhi(ga.x) * pa[1] + bfhi(gb.x) * pb[1]);
          o.y = pk2(bflo(ga.y) * pa[2] + bflo(gb.y) * pb[2], bfhi(ga.y) * pa[3] + bfhi(gb.y) * pb[3]);
          *(GAS u32x2*)((bf16_t*)(ws + WS_H) + off) = o; } }
#endif
    GRID_BAR();
#if PHMASK & 32
    { pg8::Gemm g{(const bf16_t*)(ws + WS_H), (const bf16_t*)(ws + WS_WO), NP, D, D}; pg8::StaticOrder S; S.init(NP, D, G, bid);
      if (G == (NP / 256) * (D / 256)) { EpiNorm<true> E{p.x_prompt, (bf16_t*)(ws + WS_BOUT), (bf16_t*)(ws + WS_AOUT), nullptr, p.g_norm2, (float*)(ws + WS_XS), (unsigned*)(ws + WS_PCNT), (unsigned*)(ws + WS_CTL) + 60, 32u}; pg8::gemm_phase(lds, g, S, E); }
      else { EpiRes<true> E{p.x_prompt, (bf16_t*)(ws + WS_BOUT)}; pg8::gemm_phase(lds, g, S, E); }
      for (int tl = bid; tl < 256; tl += G) { const int r0 = NP + (tl >> 5) * 64, c0 = (tl & 31) * 32;
          f32x4 acc[4][2]; ZERO_ACC42(acc);
          small_tile_mma<D>((const bf16_t*)(ws + WS_H), (const bf16_t*)(ws + WS_WO), r0, c0, wid, fr, fq, acc);
          const f32x4 pa = small_tile_reduce(lds, acc, wid, fr, fq);
          const int row = r0 + (tid >> 3), col = c0 + 4 * (tid & 7);
          const f32x4 o = *(const GAS f32x4*)(p.x_sample + (size_t)(row - NP) * D + col) + pa;
          u32x2 w; w.x = pk2(o[0], o[1]); w.y = pk2(o[2], o[3]); *(GAS u32x2*)((bf16_t*)(ws + WS_BOUT) + (size_t)row * D + col) = w; } }
#endif
    GRID_BAR();
#if PHMASK & 64
    phase_rms<true>(p, p.g_norm2, (bf16_t*)(ws + WS_AOUT), G == (NP / 256) * (D / 256) ? NP : 0);
#endif
    GRID_BAR();
#if PHMASK & 128
    { pg8::Gemm g{(const bf16_t*)(ws + WS_AOUT), (const bf16_t*)(ws + WS_WF1), MT, 2 * DFF, D}; pg8::StaticOrder S; S.init(MT, 2 * DFF, G, bid);
      EpiFfn E{(bf16_t*)(ws + WS_Z)}; pg8::gemm_phase(lds, g, S, E); }
#endif
    GRID_BAR();
#if PHMASK & 256
    { pg8::Gemm g{(const bf16_t*)(ws + WS_Z), (const bf16_t*)(ws + WS_WF2), NP, D, DFF}; pg8::StaticOrder S; S.init(NP, D, G, bid);
      if (G == (NP / 256) * (D / 256)) { EpiNorm<false> E{nullptr, (bf16_t*)(ws + WS_BOUT), nullptr, p.out + O_Y, p.g_final, (float*)(ws + WS_XS), (unsigned*)(ws + WS_PCNT), (unsigned*)(ws + WS_CTL) + 60, 64u}; pg8::gemm_phase(lds, g, S, E); }
      else { EpiRes<false> E{nullptr, (bf16_t*)(ws + WS_BOUT)}; pg8::gemm_phase(lds, g, S, E); }
      for (int tl = bid; tl < 256; tl += G) { const int r0 = NP + (tl >> 5) * 64, c0 = (tl & 31) * 32;
          f32x4 acc[4][2]; ZERO_ACC42(acc);
          small_tile_mma<DFF>((const bf16_t*)(ws + WS_Z), (const bf16_t*)(ws + WS_WF2), r0, c0, wid, fr, fq, acc);
          const f32x4 pa = small_tile_reduce(lds, acc, wid, fr, fq);
          GAS u32x2* xp2 = (GAS u32x2*)((bf16_t*)(ws + WS_BOUT) + (size_t)(r0 + (tid >> 3)) * D + c0 + 4 * (tid & 7));
          const u32x2 t = *xp2; u32x2 w; w.x = pk2(bflo(t.x) + pa[0], bfhi(t.x) + pa[1]); w.y = pk2(bflo(t.y) + pa[2], bfhi(t.y) + pa[3]); *xp2 = w; } }
#endif
    GRID_BAR();
#if PHMASK & 512
    phase_rms<false>(p, p.g_final, nullptr, G == (NP / 256) * (D / 256) ? NP : 0);
#endif
}

extern "C" void kernel_launch(void* const* d_in, const int* in_sizes, int n_in, void* d_out, int out_size, void* d_ws, size_t ws_size, hipStream_t stream) {
    static int grid_blocks = 0;
    if (grid_blocks == 0) {
        if (n_in != 25 || ws_size < WS_END) { fprintf(stderr, "kernel_launch: unexpected inputs (%d) or workspace (%zu < %zu)\n", n_in, ws_size, (size_t)WS_END); grid_blocks = -1; return; }
        int dev = 0, cus = 0, per_cu = 0;
        hipGetDevice(&dev);
        hipDeviceGetAttribute(&cus, hipDeviceAttributeMultiprocessorCount, dev);
        if (hipFuncSetAttribute((const void*)fwd_megakernel, hipFuncAttributeMaxDynamicSharedMemorySize, LDS_BYTES) != hipSuccess) { fprintf(stderr, "kernel_launch: hipFuncSetAttribute failed\n"); grid_blocks = -1; return; }
        if (hipOccupancyMaxActiveBlocksPerMultiprocessor(&per_cu, (const void*)fwd_megakernel, NT, LDS_BYTES) != hipSuccess || per_cu < 1) { fprintf(stderr, "kernel_launch: occupancy query failed (%d)\n", per_cu); (void)hipGetLastError(); per_cu = 1; }
        grid_blocks = cus * per_cu;
        if (grid_blocks > 256) grid_blocks = 256;
    }
    if (grid_blocks < 0) return;
    (void)hipMemsetAsync((char*)d_ws + WS_CTL, 0, 32768, stream);
    Params p{};
    const float* const* in = (const float* const*)d_in;
    p.x_prompt = in[0]; p.x_sample = in[1]; p.state_conv = in[2]; p.state_C = in[3]; p.state_n = in[4]; p.state_m = in[5];
    p.g_norm1 = in[6]; p.w_in = in[7]; p.b_i = in[8]; p.b_f = in[9]; p.ln_g = in[10]; p.ln_b = in[11]; p.w_s = in[12]; p.b_s = in[13];
    p.conv_w = in[14]; p.conv_b = in[15]; p.hn_g = in[16]; p.b_gate = in[17]; p.w_proj_a = in[18]; p.w_proj_b = in[19]; p.w_out = in[20];
    p.g_norm2 = in[21]; p.w_ffn_in = in[22]; p.w_ffn_out = in[23]; p.g_final = in[24];
    p.out = (float*)d_out; p.ws = (unsigned char*)d_ws;
    void* args[] = {&p};
    hipError_t e = hipLaunchCooperativeKernel((const void*)fwd_megakernel, dim3(grid_blocks), dim3(NT), args, LDS_BYTES, stream);
    if (e != hipSuccess) fprintf(stderr, "cooperative launch failed: %s (grid %d)\n", hipGetErrorString(e), grid_blocks);
}
```

```cpp
#include <hip/hip_runtime.h>
#include <hip/hip_cooperative_groups.h>
#include <cstdio>
namespace cg = cooperative_groups;

#define LAS __attribute__((address_space(3)))
#define GAS __attribute__((address_space(1)))
typedef unsigned short bf16_t;
typedef short bf16x8 __attribute__((ext_vector_type(8)));
typedef float f32x4 __attribute__((ext_vector_type(4)));
typedef float f32x2 __attribute__((ext_vector_type(2)));
typedef unsigned u32x4 __attribute__((ext_vector_type(4)));
typedef unsigned u32x2 __attribute__((ext_vector_type(2)));

constexpr int D = 1024, NP = 16384, NS = 512, MT = NP + NS;
constexpr int SEQ = 2048, NB_P = 8, NB_S = 128, TS = 4;
constexpr int INC = 8200, DFF = 2816, NZ = 8192;
constexpr float EPS = 1e-6f;
constexpr int NWAVES = 8, NT = 512;
constexpr int LDS_BYTES = 139264;

constexpr size_t O_Y = 0, O_CONVP = 17301504, O_CP = 17350656, O_NP = 19447808, O_MP = 19456000,
                 O_CONVS = 19456032, O_CS = 20242464, O_NS = 53796896, O_MS = 53927968, O_GMV = 53928480;

constexpr size_t RSZ = (size_t)MT * D * 2;
constexpr size_t WS_CTL = 0;
constexpr size_t WS_PCNT = 16384;
constexpr size_t WS_WZ = 32768;
constexpr size_t WS_WPA = WS_WZ + (size_t)NZ * D * 2;
constexpr size_t WS_WPB = WS_WPA + (size_t)D * D * 2;
constexpr size_t WS_WO = WS_WPB + (size_t)D * D * 2;
constexpr size_t WS_WF1 = WS_WO + (size_t)D * D * 2;
constexpr size_t WS_WF2 = WS_WF1 + (size_t)2 * DFF * D * 2;
constexpr size_t WS_WSB = WS_WF2 + (size_t)D * DFF * 2;
constexpr size_t WS_G = WS_WSB + 4 * 128 * 128 * 2;
constexpr size_t WS_DEN = WS_G + (size_t)MT * 8 * 4;
constexpr size_t WS_H = WS_DEN + (size_t)MT * 4 * 4;
constexpr size_t WS_Z = WS_H + RSZ;
constexpr size_t WS_AOUT = WS_Z + 8 * RSZ;
constexpr size_t WS_BOUT = WS_AOUT + RSZ;
constexpr size_t WS_HM = WS_BOUT + RSZ;
constexpr size_t WS_QKC = WS_HM + RSZ;
constexpr size_t WS_GP = WS_QKC + 2 * RSZ;
constexpr size_t WS_XS = WS_GP + (size_t)NP * 4 * 16;
constexpr size_t WS_END = WS_XS + (size_t)NP * 4 * 4;

struct Params {
    const float *x_prompt, *x_sample, *state_conv, *state_C, *state_n, *state_m;
    const float *g_norm1, *w_in, *b_i, *b_f, *ln_g, *ln_b, *w_s, *b_s, *conv_w, *conv_b, *hn_g, *b_gate;
    const float *w_proj_a, *w_proj_b, *w_out, *g_norm2, *w_ffn_in, *w_ffn_out, *g_final;
    float* out; unsigned char* ws;
};

__device__ __forceinline__ unsigned pk2(float lo, float hi) { unsigned r; asm volatile("v_cvt_pk_bf16_f32 %0, %1, %2" : "=v"(r) : "v"(lo), "v"(hi)); return r; }
__device__ __forceinline__ float bflo(unsigned w) { return __uint_as_float(w << 16); }
__device__ __forceinline__ float bfhi(unsigned w) { return __uint_as_float(w & 0xffff0000u); }
__device__ __forceinline__ float wave_sum(float v) {
#pragma unroll
    for (int o = 1; o < 64; o <<= 1) v += __shfl_xor(v, o);
    return v;
}
__device__ __forceinline__ float sigmoid_f(float x) { return __builtin_amdgcn_rcpf(1.0f + __expf(-x)); }
__device__ __forceinline__ float silu_f(float x) { return x * sigmoid_f(x); }
#define LDS_BARRIER() do { asm volatile("s_waitcnt lgkmcnt(0)" ::: "memory"); __builtin_amdgcn_s_barrier(); asm volatile("" ::: "memory"); } while (0)
__device__ __forceinline__ void lds_fence() { asm volatile("s_waitcnt lgkmcnt(0)" ::: "memory"); }


#define XB_TMO      128
#define XB_XCNT(j)  (256  + 64 * (j))
#define XB_XSUB(j)  (1280 + 64 * (j))
#define XB_XGEN(j)  (2304 + 64 * (j))
#define XB_TOP      3328
#define XB_TOPGEN   3392
#define XCD_BAR_WORDS 3456
#define XB_SPIN_CAP (1u << 20)
__device__ __forceinline__ unsigned xb_ld(unsigned* p)              { return __hip_atomic_load(p, __ATOMIC_RELAXED, __HIP_MEMORY_SCOPE_AGENT); }
__device__ __forceinline__ unsigned xb_add(unsigned* p, unsigned v) { return __hip_atomic_fetch_add(p, v, __ATOMIC_RELAXED, __HIP_MEMORY_SCOPE_AGENT); }
__device__ __forceinline__ unsigned xb_xcc_id() { return (unsigned)__builtin_amdgcn_s_getreg((3 << 11) | 20) & 0xFu; }
#define XB_SPIN(cond, bar) do { unsigned _sp = 0; while (cond) { __builtin_amdgcn_s_sleep(1); \
    if ((++_sp & 255u) == 0u) { if (xb_ld(&(bar)[XB_TMO])) break; if (_sp > XB_SPIN_CAP) { atomicAdd(&(bar)[XB_TMO], 1u); break; } } } } while (0)
struct XcdBarrier { unsigned* bar; unsigned x; volatile LAS unsigned* st; };
__device__ __forceinline__ XcdBarrier xcd_barrier_post(unsigned* bar, volatile LAS unsigned* st) {
    XcdBarrier b; b.bar = bar; b.x = xb_xcc_id(); b.st = st;
    if (threadIdx.x == 0) (void)xb_add(&bar[XB_XCNT(b.x)], 1u);
    return b;
}
__device__ __forceinline__ void xcd_barrier_complete(unsigned* bar, unsigned x, unsigned& nloc, unsigned& nx) {
    const unsigned G = gridDim.x * gridDim.y * gridDim.z;
    unsigned sum, cnt, mine, sp = 0u;
    for (;;) {
        sum = 0u; cnt = 0u; mine = 0u;
#pragma unroll
        for (unsigned j = 0; j < 16; ++j) { const unsigned c = xb_ld(&bar[XB_XCNT(j)]); sum += c; cnt += (c > 0u) ? 1u : 0u; mine = (j == x) ? c : mine; }
        if (sum == G) break;
        __builtin_amdgcn_s_sleep(1);
        if ((++sp & 255u) == 0u) { if (xb_ld(&bar[XB_TMO])) break; if (sp > XB_SPIN_CAP) { atomicAdd(&bar[XB_TMO], 1u); break; } }
    }
    nloc = mine > 0u ? mine : 1u; nx = cnt > 0u ? cnt : 1u;
}
__device__ __forceinline__ void xcd_barrier(const XcdBarrier& b) {
    asm volatile("s_waitcnt vmcnt(0)" ::: "memory");
    __syncthreads();
    if (threadIdx.x == 0) {
        unsigned* bar = b.bar;
        __builtin_amdgcn_s_waitcnt(0);
        unsigned nloc = b.st[0], nx = b.st[1];
        if (nloc == 0u) { xcd_barrier_complete(bar, b.x, nloc, nx); b.st[0] = nloc; b.st[1] = nx; }
        const unsigned old = xb_add(&bar[XB_XSUB(b.x)], 1u);
        const unsigned gen = old / nloc;
        if (old + 1u == (gen + 1u) * nloc) {
            __builtin_amdgcn_fence(__ATOMIC_RELEASE, "agent");
            asm volatile("s_waitcnt vmcnt(0)" ::: "memory");
            const unsigned og = xb_add(&bar[XB_TOP], 1u);
            const unsigned tg = og / nx;
            if (og + 1u == (tg + 1u) * nx) xb_add(&bar[XB_TOPGEN], 1u);
            else XB_SPIN(xb_ld(&bar[XB_TOPGEN]) == tg, bar);
            __builtin_amdgcn_fence(__ATOMIC_ACQUIRE, "agent");
            xb_add(&bar[XB_XGEN(b.x)], 1u);
            asm volatile("s_waitcnt vmcnt(0)" ::: "memory");
        } else {
            XB_SPIN(xb_ld(&bar[XB_XGEN(b.x)]) == gen, bar);
            __builtin_amdgcn_fence(__ATOMIC_ACQUIRE, "agent");
            asm volatile("s_waitcnt vmcnt(0)" ::: "memory");
        }
    }
    __syncthreads();
}

template <int K>
__device__ __forceinline__ void small_tile_mma(const bf16_t* A, const bf16_t* Bt, int r0, int c0, int wid, int fr, int fq, f32x4 (&acc)[4][2]) {
    constexpr int KS = K / 8;
    const bf16_t* ap = A + (size_t)(r0 + fr) * K + wid * KS + 8 * fq;
    const bf16_t* bp = Bt + (size_t)(c0 + fr) * K + wid * KS + 8 * fq;
#pragma unroll 2
    for (int ks = 0; ks < KS; ks += 32) {
        bf16x8 a[4], b[2];
#pragma unroll
        for (int mi = 0; mi < 4; ++mi) a[mi] = *(const GAS bf16x8*)(ap + (size_t)(16 * mi) * K + ks);
#pragma unroll
        for (int ni = 0; ni < 2; ++ni) b[ni] = *(const GAS bf16x8*)(bp + (size_t)(16 * ni) * K + ks);
#pragma unroll
        for (int mi = 0; mi < 4; ++mi)
#pragma unroll
            for (int ni = 0; ni < 2; ++ni) acc[mi][ni] = __builtin_amdgcn_mfma_f32_16x16x32_bf16(b[ni], a[mi], acc[mi][ni], 0, 0, 0);
    }
}
__device__ __forceinline__ f32x4 small_tile_reduce(LAS unsigned char* lds, const f32x4 (&acc)[4][2], int wid, int fr, int fq) {
    LAS float* RED = (LAS float*)lds;
    __syncthreads();
#pragma unroll
    for (int mi = 0; mi < 4; ++mi)
#pragma unroll
        for (int ni = 0; ni < 2; ++ni) *(LAS f32x4*)(RED + (wid * 64 + 16 * mi + fr) * 32 + 16 * ni + 4 * fq) = acc[mi][ni];
    __syncthreads();
    const int tid = threadIdx.x, row = tid >> 3, cq = tid & 7;
    f32x4 s = (f32x4){0.f, 0.f, 0.f, 0.f};
#pragma unroll
    for (int w = 0; w < 8; ++w) s += *(const LAS f32x4*)(RED + (w * 64 + row) * 32 + 4 * cq);
    return s;
}
#define ZERO_ACC42(acc) _Pragma("unroll") for (int _m = 0; _m < 4; ++_m) _Pragma("unroll") for (int _n = 0; _n < 2; ++_n) acc[_m][_n] = (f32x4){0.f, 0.f, 0.f, 0.f}

namespace pg8 {
constexpr int BM = 256, BK = 64, HALF = 128, HTB = HALF * BK * 2, STAGE_BYTES = 8 * HTB, NXCD = 8, WGM = 8;
__device__ __forceinline__ int lds_byte(int r, int c) { const int st = (r >> 4) * 2 + (c >> 5), rr = r & 15, cc = c & 31, ob = rr * 64 + cc * 2; return st * 1024 + (ob ^ (((ob >> 9) & 1) << 5)); }
__device__ __forceinline__ void stage_rc(int b, int& R, int& C) { const int st = b / 1024, sb = b % 1024, swz = sb ^ (((sb >> 9) & 1) << 5); R = (st >> 1) * 16 + swz / 64; C = (st & 1) * 32 + (swz % 64) / 2; }
__device__ __forceinline__ int perm32(int rho) { const int n = rho >> 4, i = rho & 15; return 8 * (i >> 2) + 4 * n + (i & 3); }
struct Unit { int pm, pn; };
struct Gemm { const bf16_t* A; const bf16_t* Bt; int M, N, K; };
struct StaticOrder {
    int nM, nN, nwg, G, c;
    __device__ void init(int M, int N, int G_, int c_) { nM = M / BM; nN = N / BM; nwg = nM * nN; G = G_; c = c_; }
    __device__ bool next(int i, Unit& u) const {
        const long L = (long)i * G + c; if (L >= nwg) return false;
        int wgid = (int)L; { const int q = nwg / NXCD, r = nwg % NXCD, xcd = wgid % NXCD, off = wgid / NXCD; wgid = (xcd < r ? xcd * (q + 1) : r * (q + 1) + (xcd - r) * q) + off; }
        const int nig = WGM * nN, gid = wgid / nig, fm = gid * WGM, gsz = (nM - fm) < WGM ? (nM - fm) : WGM;
        u.pm = fm + ((wgid % nig) % gsz); u.pn = (wgid % nig) / gsz; return true;
    }
    __device__ __forceinline__ void a_ready(const Unit&) const {}
    __device__ __forceinline__ void done(const Unit&) const {}
};

template <class Epi, class Sched>
__device__ __forceinline__ void gemm_phase(LAS unsigned char* lds, const Gemm g, const Sched& S, const Epi& E) {
    const int tid = threadIdx.x, wid = __builtin_amdgcn_readfirstlane(tid >> 6), lane = tid & 63, wr = wid >> 2, wc = wid & 3, fr = lane & 15, fq = lane >> 4;
    const int K = g.K, nt = K / BK;
    unsigned voffA[2], voffB[2];
#pragma unroll
    for (int i = 0; i < 2; ++i) { int R, C; stage_rc(tid * 16 + i * 8192, R, C); const int Rb = Epi::PERM ? ((R & ~31) + perm32(R & 31)) : R;
        voffA[i] = (unsigned)(R * K + C) * 2u; voffB[i] = (unsigned)(Rb * K + C) * 2u; }
    const size_t kstep = (size_t)(BK * 2);
    const size_t hstep = (size_t)HALF * K * 2;
    const size_t tstep = 2 * hstep;
    const unsigned ldsw = (unsigned)wid * 1024u;
    const int aoff = lds_byte(wr * 64 + fr, fq * 8), boff = lds_byte(wc * 32 + fr, fq * 8);
#define PG8_SA(b, h) (((b) * 2 + (h)) * HTB)
#define PG8_SB(b, h) ((4 + (b) * 2 + (h)) * HTB)
#define PG8_STAGE(bufoff, gbase, voff) do { _Pragma("unroll") for (int _i = 0; _i < 2; ++_i) \
        __builtin_amdgcn_global_load_lds((const unsigned*)((const char*)(gbase) + (voff)[_i]), (LAS unsigned*)(lds + (bufoff) + ldsw + _i * 8192), 16, 0, 0); } while (0)
#define PG8_LDA(dst, b, h) do { _Pragma("unroll") for (int m = 0; m < 4; ++m) _Pragma("unroll") for (int k = 0; k < 2; ++k) dst[m][k] = *(const LAS bf16x8*)(lds + PG8_SA(b, h) + aoff + m * 2048 + k * 1024); } while (0)
#define PG8_LDB(dst, b, h) do { _Pragma("unroll") for (int n = 0; n < 2; ++n) _Pragma("unroll") for (int k = 0; k < 2; ++k) dst[n][k] = *(const LAS bf16x8*)(lds + PG8_SB(b, h) + boff + n * 2048 + k * 1024); } while (0)
#define PG8_MMA(ai, bj, At, Bt) do { __builtin_amdgcn_s_setprio(1); _Pragma("unroll") for (int m = 0; m < 4; ++m) _Pragma("unroll") for (int n = 0; n < 2; ++n) _Pragma("unroll") for (int k = 0; k < 2; ++k) \
        acc[ai][bj][m][n] = __builtin_amdgcn_mfma_f32_16x16x32_bf16(Bt[n][k], At[m][k], acc[ai][bj][m][n], 0, 0, 0); __builtin_amdgcn_s_setprio(0); } while (0)
#define PG8_WAIT_V(n) asm volatile("s_waitcnt vmcnt(" #n ")" ::: "memory")
#define PG8_WAIT_L(n) asm volatile("s_waitcnt lgkmcnt(" #n ")" ::: "memory")
#define PG8_BAR __builtin_amdgcn_s_barrier()
#define PG8_SCHED __builtin_amdgcn_sched_barrier(0)
    Unit cur, nxt; int ui = 0;
    if (!S.next(0, cur)) return;
    f32x4 acc[2][2][4][2];
#pragma unroll
    for (int a = 0; a < 2; ++a)
#pragma unroll
        for (int b = 0; b < 2; ++b)
#pragma unroll
            for (int m = 0; m < 4; ++m)
#pragma unroll
                for (int n = 0; n < 2; ++n) acc[a][b][m][n] = (f32x4){0.f, 0.f, 0.f, 0.f};
    bf16x8 At[4][2], B0[2][2], B1[2][2];
    const char* cA = (const char*)g.A + (size_t)cur.pm * tstep; const char* cB = (const char*)g.Bt + (size_t)cur.pn * tstep;
    S.a_ready(cur);
    PG8_STAGE(PG8_SB(0, 0), cB, voffB); PG8_STAGE(PG8_SA(0, 0), cA, voffA); PG8_STAGE(PG8_SB(0, 1), cB + hstep, voffB); PG8_STAGE(PG8_SA(0, 1), cA + hstep, voffA);
    if (wr == 1) PG8_BAR;
    PG8_WAIT_V(4); PG8_BAR;
    PG8_STAGE(PG8_SB(1, 0), cB + kstep, voffB); PG8_STAGE(PG8_SA(1, 0), cA + kstep, voffA); PG8_STAGE(PG8_SB(1, 1), cB + hstep + kstep, voffB);
    PG8_WAIT_V(6); PG8_BAR;
    for (;;) {
        const bool has_next = S.next(ui + 1, nxt);
        const char* nA = has_next ? (const char*)g.A + (size_t)nxt.pm * tstep : cA; const char* nB = has_next ? (const char*)g.Bt + (size_t)nxt.pn * tstep : cB;
        for (int t = 0; t < nt; t += 2) {
            const bool last = (t == nt - 2);
            const char* a1 = cA + (size_t)(t + 1) * kstep;
            const char* a2 = last ? nA : cA + (size_t)(t + 2) * kstep; const char* b2 = last ? nB : cB + (size_t)(t + 2) * kstep;
            const char* a3 = a2 + kstep; const char* b3 = b2 + kstep;
            if (last && has_next) S.a_ready(nxt);
            PG8_LDB(B0, 0, 0); PG8_SCHED; PG8_LDA(At, 0, 0); PG8_STAGE(PG8_SA(1, 1), a1 + hstep, voffA);
            PG8_WAIT_L(8); PG8_BAR; PG8_WAIT_L(0); PG8_MMA(0, 0, At, B0); PG8_BAR; PG8_SCHED;
            PG8_LDB(B1, 0, 1); PG8_STAGE(PG8_SB(0, 0), b2, voffB);
            PG8_BAR; PG8_WAIT_L(0); PG8_MMA(0, 1, At, B1); PG8_BAR;
            PG8_LDA(At, 0, 1); PG8_STAGE(PG8_SA(0, 0), a2, voffA);
            PG8_BAR; PG8_WAIT_L(0); PG8_MMA(1, 0, At, B0); PG8_BAR; PG8_SCHED;
            PG8_STAGE(PG8_SB(0, 1), b2 + hstep, voffB);
            PG8_WAIT_V(6); PG8_BAR; PG8_MMA(1, 1, At, B1); PG8_BAR;
            PG8_LDB(B0, 1, 0); PG8_SCHED; PG8_LDA(At, 1, 0); PG8_STAGE(PG8_SA(0, 1), a2 + hstep, voffA);
            PG8_WAIT_L(8); PG8_BAR; PG8_WAIT_L(0); PG8_MMA(0, 0, At, B0); PG8_BAR; PG8_SCHED;
            PG8_LDB(B1, 1, 1); PG8_STAGE(PG8_SB(1, 0), b3, voffB);
            PG8_BAR; PG8_WAIT_L(0); PG8_MMA(0, 1, At, B1); PG8_BAR;
            PG8_LDA(At, 1, 1); PG8_STAGE(PG8_SA(1, 0), a3, voffA);
            PG8_BAR; PG8_WAIT_L(0); PG8_MMA(1, 0, At, B0); PG8_BAR; PG8_SCHED;
            PG8_STAGE(PG8_SB(1, 1), b3 + hstep, voffB);
            PG8_WAIT_V(6); PG8_BAR; PG8_MMA(1, 1, At, B1); PG8_BAR;
        }
        if constexpr (!Epi::AFTER_DRAIN) { E(acc, cur, wr, wc, fr, fq); S.done(cur); }
        if (!has_next) break;
#pragma unroll
        for (int a = 0; a < 2; ++a)
#pragma unroll
            for (int b = 0; b < 2; ++b)
#pragma unroll
                for (int m = 0; m < 4; ++m)
#pragma unroll
                    for (int n = 0; n < 2; ++n) acc[a][b][m][n] = (f32x4){0.f, 0.f, 0.f, 0.f};
        cur = nxt; cA = nA; cB = nB; ++ui;
    }
    PG8_WAIT_V(0);
    if (wr == 0) PG8_BAR;
    PG8_BAR;
    if constexpr (Epi::AFTER_DRAIN) { E.fused(acc, cur, wr, wc, fr, fq, lds, wid, lane); S.done(cur); }
#undef PG8_SA
#undef PG8_SB
#undef PG8_STAGE
#undef PG8_LDA
#undef PG8_LDB
#undef PG8_MMA
#undef PG8_WAIT_V
#undef PG8_WAIT_L
#undef PG8_BAR
#undef PG8_SCHED
}
}
using pg8::Unit; using pg8::HALF; using pg8::BM;

__device__ __forceinline__ f32x2 gelu_pk(f32x2 v) {
    const f32x2 av = __builtin_elementwise_abs(v), d = av * 0.2316418882f + 1.0f;
    f32x2 t; t.x = __builtin_amdgcn_rcpf(d.x); t.y = __builtin_amdgcn_rcpf(d.y);
    f32x2 q = t * 0.5307027145f + (-0.7265760135f); q = q * t + 0.7107068705f; q = q * t + (-0.142248368f); q = q * t + 0.127414796f; q = q * t;
    const f32x2 s = (v * v) * (-0.72134752044f);
    f32x2 e; e.x = __builtin_amdgcn_exp2f(s.x); e.y = __builtin_amdgcn_exp2f(s.y);
    const f32x2 m = v * (q * e), r = v - m;
    f32x2 o; o.x = v.x < 0.f ? m.x : r.x; o.y = v.y < 0.f ? m.y : r.y; return o;
}

struct EpiZ {
    static constexpr bool PERM = true, AFTER_DRAIN = false;
    bf16_t* Z; const float* b_gate;
    __device__ __forceinline__ void operator()(const f32x4 (&acc)[2][2][4][2], const Unit& u, int wr, int wc, int fr, int fq) const {
        const int sec = u.pn >> 2; int colt = (u.pn & 3) * BM; bf16_t* base; int ldc;
        if (sec == 2 || sec == 3) { base = Z + (size_t)2 * MT * D; ldc = 2 * D; colt += (sec - 2) * D; } else { base = Z + (size_t)sec * MT * D; ldc = D; }
        const int row0 = u.pm * BM + wr * 64 + fr, col0 = colt + wc * 32 + 8 * fq;
        const int gcol0 = (u.pn & 3) * BM + wc * 32 + 8 * fq;
        f32x4 bv[2][2];
#pragma unroll
        for (int bj = 0; bj < 2; ++bj)
#pragma unroll
            for (int n = 0; n < 2; ++n) bv[bj][n] = (sec >= 6) ? *(const GAS f32x4*)(b_gate + (sec - 6) * D + gcol0 + bj * HALF + 4 * n) : (f32x4){0.f, 0.f, 0.f, 0.f};
#pragma unroll
        for (int ai = 0; ai < 2; ++ai)
#pragma unroll
            for (int m = 0; m < 4; ++m) { bf16_t* rowp = base + (size_t)(row0 + ai * HALF + m * 16) * ldc + col0;
#pragma unroll
                for (int bj = 0; bj < 2; ++bj) { f32x4 v0 = acc[ai][bj][m][0] + bv[bj][0], v1 = acc[ai][bj][m][1] + bv[bj][1];
                    if (false) { }
                    else if (sec >= 6) {
#pragma unroll
                        for (int j = 0; j < 4; ++j) { v0[j] = sigmoid_f(v0[j]); v1[j] = sigmoid_f(v1[j]); } }
                    u32x4 w; w.x = pk2(v0[0], v0[1]); w.y = pk2(v0[2], v0[3]); w.z = pk2(v1[0], v1[1]); w.w = pk2(v1[2], v1[3]);
                    __builtin_nontemporal_store(w, (GAS u32x4*)(rowp + bj * HALF)); } }
    }
};
struct EpiT1 {
    static constexpr bool PERM = true, AFTER_DRAIN = false;
    bf16_t* T; const bf16_t* SG;
    __device__ __forceinline__ void operator()(const f32x4 (&acc)[2][2][4][2], const Unit& u, int wr, int wc, int fr, int fq) const {
        const int row0 = u.pm * BM + wr * 64 + fr, col0 = u.pn * BM + wc * 32 + 8 * fq;
#pragma unroll
        for (int ai = 0; ai < 2; ++ai)
#pragma unroll
            for (int m = 0; m < 4; ++m) { const size_t off = (size_t)(row0 + ai * HALF + m * 16) * D + col0;
#pragma unroll
                for (int bj = 0; bj < 2; ++bj) { const u32x4 s = *(const GAS u32x4*)(SG + off + bj * HALF);
                    const f32x4 o0 = acc[ai][bj][m][0], o1 = acc[ai][bj][m][1];
                    u32x4 w; w.x = pk2(o0[0] * bflo(s.x), o0[1] * bfhi(s.x)); w.y = pk2(o0[2] * bflo(s.y), o0[3] * bfhi(s.y));
                    w.z = pk2(o1[0] * bflo(s.z), o1[1] * bfhi(s.z)); w.w = pk2(o1[2] * bflo(s.w), o1[3] * bfhi(s.w));
                    *(GAS u32x4*)(T + off + bj * HALF) = w; } }
    }
};
struct EpiT2 {
    static constexpr bool PERM = true, AFTER_DRAIN = false;
    const bf16_t* T; const bf16_t* SG; bf16_t* O;
    __device__ __forceinline__ void operator()(const f32x4 (&acc)[2][2][4][2], const Unit& u, int wr, int wc, int fr, int fq) const {
        const int row0 = u.pm * BM + wr * 64 + fr, col0 = u.pn * BM + wc * 32 + 8 * fq;
#pragma unroll
        for (int ai = 0; ai < 2; ++ai)
#pragma unroll
            for (int m = 0; m < 4; ++m) { const size_t off = (size_t)(row0 + ai * HALF + m * 16) * D + col0;
#pragma unroll
                for (int bj = 0; bj < 2; ++bj) { const u32x4 s = *(const GAS u32x4*)(SG + off + bj * HALF), t = *(const GAS u32x4*)(T + off + bj * HALF);
                    const f32x4 o0 = acc[ai][bj][m][0], o1 = acc[ai][bj][m][1];
                    u32x4 w; w.x = pk2(bflo(t.x) + o0[0] * bflo(s.x), bfhi(t.x) + o0[1] * bfhi(s.x)); w.y = pk2(bflo(t.y) + o0[2] * bflo(s.y), bfhi(t.y) + o0[3] * bfhi(s.y));
                    w.z = pk2(bflo(t.z) + o1[0] * bflo(s.z), bfhi(t.z) + o1[1] * bfhi(s.z)); w.w = pk2(bflo(t.w) + o1[2] * bflo(s.w), bfhi(t.w) + o1[3] * bfhi(s.w));
                    *(GAS u32x4*)(O + off + bj * HALF) = w; } }
    }
};
template <bool FIRST> struct EpiRes {
    static constexpr bool PERM = true, AFTER_DRAIN = false;
    const float* xp; bf16_t* XB;
    __device__ __forceinline__ void operator()(const f32x4 (&acc)[2][2][4][2], const Unit& u, int wr, int wc, int fr, int fq) const {
        const int row0 = u.pm * BM + wr * 64 + fr, col0 = u.pn * BM + wc * 32 + 8 * fq;
#pragma unroll
        for (int ai = 0; ai < 2; ++ai)
#pragma unroll
            for (int m = 0; m < 4; ++m) { const size_t off = (size_t)(row0 + ai * HALF + m * 16) * D + col0;
#pragma unroll
                for (int bj = 0; bj < 2; ++bj) { f32x4 b0, b1;
                    if (FIRST) { b0 = *(const GAS f32x4*)(xp + off + bj * HALF); b1 = *(const GAS f32x4*)(xp + off + bj * HALF + 4); }
                    else { const u32x4 t = *(const GAS u32x4*)(XB + off + bj * HALF); b0 = (f32x4){bflo(t.x), bfhi(t.x), bflo(t.y), bfhi(t.y)}; b1 = (f32x4){bflo(t.z), bfhi(t.z), bflo(t.w), bfhi(t.w)}; }
                    const f32x4 o0 = b0 + acc[ai][bj][m][0], o1 = b1 + acc[ai][bj][m][1];
                    u32x4 w; w.x = pk2(o0[0], o0[1]); w.y = pk2(o0[2], o0[3]); w.z = pk2(o1[0], o1[1]); w.w = pk2(o1[2], o1[3]);
                    *(GAS u32x4*)(XB + off + bj * HALF) = w; } }
    }
};
template <bool FIRST> struct EpiNorm {
    static constexpr bool PERM = true, AFTER_DRAIN = true;
    const float* xp; bf16_t* XB; bf16_t* H2; float* Y; const float* gain; float* xs; unsigned* cnt; unsigned* tmo; unsigned want;
    __device__ __forceinline__ void fused(f32x4 (&acc)[2][2][4][2], const Unit& u, int wr, int wc, int fr, int fq, LAS unsigned char* lds, int wid, int lane) const {
        LAS float* P = (LAS float*)lds;
        LAS float* S = (LAS float*)(lds + 4096);
        const int row0 = u.pm * BM + wr * 64 + fr, col0 = u.pn * BM + wc * 32 + 8 * fq;
#pragma unroll
        for (int ai = 0; ai < 2; ++ai)
#pragma unroll
            for (int m = 0; m < 4; ++m) { const size_t off = (size_t)(row0 + ai * HALF + m * 16) * D + col0; float ss = 0.f;
#pragma unroll
                for (int bj = 0; bj < 2; ++bj) { f32x4& a0 = acc[ai][bj][m][0]; f32x4& a1 = acc[ai][bj][m][1];
                    if (FIRST) { a0 += *(const GAS f32x4*)(xp + off + bj * HALF); a1 += *(const GAS f32x4*)(xp + off + bj * HALF + 4);
                        u32x4 w; w.x = pk2(a0[0], a0[1]); w.y = pk2(a0[2], a0[3]); w.z = pk2(a1[0], a1[1]); w.w = pk2(a1[2], a1[3]); *(GAS u32x4*)(XB + off + bj * HALF) = w; }
                    else { const u32x4 t = *(const GAS u32x4*)(XB + off + bj * HALF);
                        a0[0] += bflo(t.x); a0[1] += bfhi(t.x); a0[2] += bflo(t.y); a0[3] += bfhi(t.y); a1[0] += bflo(t.z); a1[1] += bfhi(t.z); a1[2] += bflo(t.w); a1[3] += bfhi(t.w); }
                    ss += ((a0[0] * a0[0] + a0[1] * a0[1]) + (a0[2] * a0[2] + a0[3] * a0[3])) + ((a1[0] * a1[0] + a1[1] * a1[1]) + (a1[2] * a1[2] + a1[3] * a1[3])); }
                ss += __shfl_xor(ss, 16); ss += __shfl_xor(ss, 32);
                if (fq == 0) P[(ai * HALF + wr * 64 + m * 16 + fr) * 4 + wc] = ss; }
        asm volatile("s_waitcnt lgkmcnt(0)" ::: "memory"); __builtin_amdgcn_s_barrier(); asm volatile("" ::: "memory");
        const int row = wid * 32 + (lane & 31);
        if (lane < 32) { const f32x4 q = *(const LAS f32x4*)(P + row * 4);
            __hip_atomic_store(xs + ((size_t)(u.pm * BM + row) * 4 + u.pn), (q[0] + q[1]) + (q[2] + q[3]), __ATOMIC_RELAXED, __HIP_MEMORY_SCOPE_AGENT); }
        asm volatile("s_waitcnt vmcnt(0)" ::: "memory");
        if (lane == 0) (void)__hip_atomic_fetch_add(cnt + 64 * u.pm, 1u, __ATOMIC_RELAXED, __HIP_MEMORY_SCOPE_AGENT);
        if (wid == 0) { unsigned sp = 0;
            while ((unsigned)__builtin_amdgcn_readfirstlane(__hip_atomic_load(cnt + 64 * u.pm, __ATOMIC_RELAXED, __HIP_MEMORY_SCOPE_AGENT)) < want) {
                __builtin_amdgcn_s_sleep(2); if (++sp > (1u << 20)) { if (lane == 0) __hip_atomic_store(tmo, 1u, __ATOMIC_RELAXED, __HIP_MEMORY_SCOPE_AGENT); break; } }
            __builtin_amdgcn_fence(__ATOMIC_ACQUIRE, "agent"); }
        asm volatile("s_waitcnt vmcnt(0) lgkmcnt(0)" ::: "memory"); __builtin_amdgcn_s_barrier(); asm volatile("" ::: "memory");
        if (lane < 32) { const float* sl = xs + (size_t)(u.pm * BM + row) * 4; float t = 0.f;
#pragma unroll
            for (int j = 0; j < 4; ++j) t += __hip_atomic_load(sl + j, __ATOMIC_RELAXED, __HIP_MEMORY_SCOPE_AGENT);
            S[row] = rsqrtf(t * (1.0f / D) + EPS); }
        asm volatile("s_waitcnt vmcnt(0) lgkmcnt(0)" ::: "memory"); __builtin_amdgcn_s_barrier(); asm volatile("" ::: "memory");
        f32x4 gv[2][2];
#pragma unroll
        for (int bj = 0; bj < 2; ++bj) { gv[bj][0] = *(const GAS f32x4*)(gain + col0 + bj * HALF); gv[bj][1] = *(const GAS f32x4*)(gain + col0 + bj * HALF + 4); }
#pragma unroll
        for (int ai = 0; ai < 2; ++ai)
#pragma unroll
            for (int m = 0; m < 4; ++m) { const int r = ai * HALF + wr * 64 + m * 16 + fr; const float rs = S[r]; const size_t off = (size_t)(u.pm * BM + r) * D + col0;
#pragma unroll
                for (int bj = 0; bj < 2; ++bj) { const f32x4 o0 = acc[ai][bj][m][0] * rs * gv[bj][0], o1 = acc[ai][bj][m][1] * rs * gv[bj][1];
                    if (FIRST) { u32x4 w; w.x = pk2(o0[0], o0[1]); w.y = pk2(o0[2], o0[3]); w.z = pk2(o1[0], o1[1]); w.w = pk2(o1[2], o1[3]); *(GAS u32x4*)(H2 + off + bj * HALF) = w; }
                    else { *(GAS f32x4*)(Y + off + bj * HALF) = o0; *(GAS f32x4*)(Y + off + bj * HALF + 4) = o1; } } }
    }
};
struct EpiFfn {
    static constexpr bool PERM = true, AFTER_DRAIN = false;
    bf16_t* ACT;
    __device__ __forceinline__ void operator()(const f32x4 (&acc)[2][2][4][2], const Unit& u, int wr, int wc, int fr, int fq) const {
        const int row0 = u.pm * BM + wr * 64 + fr, col0 = u.pn * HALF + wc * 32 + 8 * fq;
#pragma unroll
        for (int ai = 0; ai < 2; ++ai)
#pragma unroll
            for (int m = 0; m < 4; ++m) { bf16_t* rowp = ACT + (size_t)(row0 + ai * HALF + m * 16) * DFF + col0;
                f32x4 o0, o1;
#pragma unroll
                for (int j = 0; j < 4; ++j) { o0[j] = silu_f(acc[ai][0][m][0][j]) * acc[ai][1][m][0][j]; o1[j] = silu_f(acc[ai][0][m][1][j]) * acc[ai][1][m][1][j]; }
                u32x4 w; w.x = pk2(o0[0], o0[1]); w.y = pk2(o0[2], o0[3]); w.z = pk2(o1[0], o1[1]); w.w = pk2(o1[2], o1[3]);
                *(GAS u32x4*)rowp = w; }
    }
};

__device__ __forceinline__ void transpose_item(const float* W, int ldw, int K, bf16_t* WT, int k0, int srccol0, int dstrow0, LAS float* scr, int lane) {
    { const int kr = lane >> 3, nq = lane & 7;
      f32x4 wv[8];
#pragma unroll
      for (int i = 0; i < 8; ++i) wv[i] = *(const GAS f32x4*)(W + (size_t)(k0 + 8 * i + kr) * ldw + srccol0 + 4 * nq);
#pragma unroll
      for (int i = 0; i < 8; ++i) { LAS float* d = scr + (8 * i + kr) * 33 + 4 * nq; d[0] = wv[i][0]; d[1] = wv[i][1]; d[2] = wv[i][2]; d[3] = wv[i][3]; } }
    lds_fence();
    const int c = lane & 7;
#pragma unroll
    for (int j = 0; j < 4; ++j) { const int n = (lane >> 3) + 8 * j; const LAS float* s = scr + (8 * c) * 33 + n;
        u32x4 o; o.x = pk2(s[0 * 33], s[1 * 33]); o.y = pk2(s[2 * 33], s[3 * 33]); o.z = pk2(s[4 * 33], s[5 * 33]); o.w = pk2(s[6 * 33], s[7 * 33]);
        *(GAS u32x4*)(WT + (size_t)(dstrow0 + n) * K + k0 + 8 * c) = o; }
    lds_fence();
}

__device__ __forceinline__ void phase0(const Params& p, LAS unsigned char* lds) {
    const int tid = threadIdx.x, lane = tid & 63, wid = tid >> 6;
    const int gw = blockIdx.x * NWAVES + wid, NGW = gridDim.x * NWAVES;
    unsigned char* ws = p.ws;
    LAS float* scr = (LAS float*)(lds + wid * 8448);
    LAS float* gwl = (LAS float*)(lds + 69632);
    for (int i = tid; i < 8192; i += NT) { const int k = i >> 3, c = i & 7; gwl[c * 1024 + k] = p.w_in[(size_t)k * INC + 6144 + c]; }
    for (int it = gw; it < 16 * 256; it += NGW) { const int kb = it / 256, nb = it % 256, n0 = nb * 32; transpose_item(p.w_in, INC, D, (bf16_t*)(ws + WS_WZ), kb * 64, n0 < 6144 ? n0 : n0 + 8, n0, scr, lane); }
    { bf16_t* wsb = (bf16_t*)(ws + WS_WSB);
      for (int i = blockIdx.x * NT + tid; i < 4 * 128 * 128 / 2; i += gridDim.x * NT) { const int e = 2 * i, s = e & 127, t = (e >> 7) & 127;
          const float a = s <= t ? p.w_s[e] : 0.f, b = (s + 1) <= t ? p.w_s[e + 1] : 0.f; ((unsigned*)wsb)[i] = pk2(a, b); } }
    __syncthreads();
    bf16_t* H = (bf16_t*)(ws + WS_H); float* G = (float*)(ws + WS_G);
    f32x4 g1v[4];
#pragma unroll
    for (int j = 0; j < 4; ++j) g1v[j] = ((const GAS f32x4*)p.g_norm1)[lane + 64 * j];
    for (int row0 = gw; row0 < MT; row0 += 2 * NGW) {
        f32x4 vv[2][4];
#pragma unroll
        for (int rr = 0; rr < 2; ++rr) { const int row = (row0 + rr * NGW < MT) ? row0 + rr * NGW : row0;
            const GAS float* xr = row < NP ? (const GAS float*)p.x_prompt + (size_t)row * D : (const GAS float*)p.x_sample + (size_t)(row - NP) * D;
#pragma unroll
            for (int j = 0; j < 4; ++j) vv[rr][j] = ((const GAS f32x4*)xr)[lane + 64 * j]; }
#pragma unroll
        for (int rr = 0; rr < 2; ++rr) { const int row = row0 + rr * NGW; if (row < MT) {
            f32x4 v[4]; float ss = 0.f;
#pragma unroll
            for (int j = 0; j < 4; ++j) { v[j] = vv[rr][j]; ss += (v[j][0] * v[j][0] + v[j][1] * v[j][1]) + (v[j][2] * v[j][2] + v[j][3] * v[j][3]); }
            const float r = rsqrtf(wave_sum(ss) * (1.0f / D) + EPS);
#pragma unroll
            for (int j = 0; j < 4; ++j) { v[j] = v[j] * r * g1v[j];
                u32x2 o; o.x = pk2(v[j][0], v[j][1]); o.y = pk2(v[j][2], v[j][3]); ((GAS u32x2*)((GAS bf16_t*)H + (size_t)row * D))[lane + 64 * j] = o; }
            float ga[8];
#pragma unroll
            for (int c = 0; c < 8; ++c) { float a = 0.f;
#pragma unroll
                for (int j = 0; j < 4; ++j) { const f32x4 w4 = ((const LAS f32x4*)(gwl + c * 1024))[lane + 64 * j]; a += (v[j][0] * w4[0] + v[j][1] * w4[1]) + (v[j][2] * w4[2] + v[j][3] * w4[3]); }
                ga[c] = wave_sum(a); }
            if (lane == 0) {
#pragma unroll
                for (int c = 0; c < 4; ++c) G[(size_t)row * 8 + c] = ga[c] + p.b_i[c];
#pragma unroll
                for (int c = 0; c < 4; ++c) { const float xx = ga[4 + c] + p.b_f[c]; G[(size_t)row * 8 + 4 + c] = fminf(xx, 0.f) - log1pf(expf(-fabsf(xx))); }
            } } }
    }
}

constexpr int QS_LD = 264, CS_LD = 264;
constexpr int OFF_QS = 0, OFF_KK = 33792, OFF_VT = 70656, OFF_SS = 82176, OFF_CS = 91392, OFF_GT = 133632;

__device__ __forceinline__ void load_raw4(float (&r)[4], const bf16_t* QK, const float* sconv, int rel, size_t rowbase, int col) {
    if (rel >= 0) { const u32x2 w = *(const GAS u32x2*)(QK + (rowbase + rel) * (2 * D) + col);
        r[0] = bflo(w.x); r[1] = bfhi(w.x); r[2] = bflo(w.y); r[3] = bfhi(w.y); }
    else if (sconv) { const f32x4 a = *(const GAS f32x4*)(sconv + (size_t)(3 + rel) * (2 * D) + col);
        r[0] = a[0]; r[1] = a[1]; r[2] = a[2]; r[3] = a[3]; }
    else { r[0] = 0.f; r[1] = 0.f; r[2] = 0.f; r[3] = 0.f; }
}
__device__ __forceinline__ void conv_silu_4x4(u32x2 (&out)[4], const Params& p, const bf16_t* QK, const float* sconv, int rel0, size_t rowbase, int col, float scale) {
    f32x4 acc[4];
    { const f32x4 b0 = *(const GAS f32x4*)(p.conv_b + col);
#pragma unroll
      for (int i = 0; i < 4; ++i) acc[i] = b0; }
    f32x4 w[4];
#pragma unroll
    for (int j = 0; j < 4; ++j) w[j] = *(const GAS f32x4*)(p.conv_w + (size_t)j * 2 * D + col);
#pragma unroll
    for (int i = 0; i < 7; ++i) {
        float r[4]; load_raw4(r, QK, sconv, rel0 - 3 + i, rowbase, col);
#pragma unroll
        for (int tt = 0; tt < 4; ++tt) { const int j = i - tt; if (j >= 0 && j < 4) {
#pragma unroll
            for (int e = 0; e < 4; ++e) acc[tt][e] += w[j][e] * r[e]; } }
    }
#pragma unroll
    for (int i = 0; i < 4; ++i) {
#pragma unroll
        for (int e = 0; e < 4; ++e) acc[i][e] = silu_f(acc[i][e]) * scale;
        out[i].x = pk2(acc[i][0], acc[i][1]); out[i].y = pk2(acc[i][2], acc[i][3]); }
}

__device__ __forceinline__ void phase_conv(const Params& p) {
    int tid = threadIdx.x; asm volatile("" : "+v"(tid));
    unsigned char* ws = p.ws; asm volatile("" : "+s"(ws));
    const bf16_t* QK = (const bf16_t*)(ws + WS_Z + 2 * RSZ); bf16_t* QKC = (bf16_t*)(ws + WS_QKC);
    const int col = 4 * tid; const float sc = col < D ? 1.0f : 0.0625f;
    f32x4 w[4], bias = *(const GAS f32x4*)(p.conv_b + col);
#pragma unroll
    for (int j = 0; j < 4; ++j) w[j] = *(const GAS f32x4*)(p.conv_w + (size_t)j * 2 * D + col);
    for (int rg0 = blockIdx.x; rg0 < NP / 4; rg0 += 2 * gridDim.x) {
        u32x2 raw[2][7]; bool ok[2];
#pragma unroll
        for (int u = 0; u < 2; ++u) { const int rg = rg0 + u * gridDim.x; ok[u] = rg < NP / 4 && (rg & (SEQ / 4 - 1)) != 0; const int R = 4 * (ok[u] ? rg : (rg0 | 1));
#pragma unroll
            for (int i = 0; i < 7; ++i) raw[u][i] = ok[u] ? *(const GAS u32x2*)(QK + (size_t)(R - 3 + i) * (2 * D) + col) : (u32x2){0u, 0u}; }
#pragma unroll
        for (int u = 0; u < 2; ++u) if (ok[u]) { const int R = 4 * (rg0 + u * gridDim.x);
            f32x4 acc[4] = {bias, bias, bias, bias};
#pragma unroll
            for (int i = 0; i < 7; ++i) { const f32x4 r = (f32x4){bflo(raw[u][i].x), bfhi(raw[u][i].x), bflo(raw[u][i].y), bfhi(raw[u][i].y)};
#pragma unroll
                for (int tt = 0; tt < 4; ++tt) { const int j = i - tt; if (j >= 0 && j < 4) acc[tt] += w[j] * r; } }
#pragma unroll
            for (int i = 0; i < 4; ++i) { u32x2 o; o.x = pk2(silu_f(acc[i][0]) * sc, silu_f(acc[i][1]) * sc); o.y = pk2(silu_f(acc[i][2]) * sc, silu_f(acc[i][3]) * sc);
                *(GAS u32x2*)(QKC + (size_t)(R + i) * (2 * D) + col) = o; } }
    }
    for (int k = blockIdx.x; k < NB_P + NS / 4; k += gridDim.x) {
        const int rg = k < NB_P ? k * (SEQ / 4) : NP / 4 + (k - NB_P);
        const int R = 4 * rg; int rel0; size_t rowbase; const float* sconv;
        if (R < NP) { rel0 = R & (SEQ - 1); rowbase = (size_t)(R - rel0); sconv = nullptr; }
        else { rel0 = 0; rowbase = (size_t)R; sconv = p.state_conv + (size_t)((R - NP) >> 2) * 3 * 2 * D; }
        u32x2 o[4]; conv_silu_4x4(o, p, QK, sconv, rel0, rowbase, col, sc);
#pragma unroll
        for (int i = 0; i < 4; ++i) *(GAS u32x2*)(QKC + (size_t)(R + i) * (2 * D) + col) = o[i];
    }
}
__device__ __forceinline__ void phase_gate_scan(const Params& p) {
    int tid = threadIdx.x; asm volatile("" : "+v"(tid));
    const int lane = tid & 63, wid = tid >> 6, gw = blockIdx.x * NWAVES + wid, NGW = gridDim.x * NWAVES;
    const float* G = (const float*)(p.ws + WS_G); f32x4* GP = (f32x4*)(p.ws + WS_GP);
    for (int it = gw; it < (NP / 64) * 4; it += NGW) { const int c = it >> 2, h = it & 3; const size_t row = (size_t)c * 64 + lane;
        const float ic = G[row * 8 + h], fc = G[row * 8 + 4 + h];
        float bc = fc;
#pragma unroll
        for (int o = 1; o < 64; o <<= 1) { const float uu = __shfl_up(bc, o); if (lane >= o) bc += uu; }
        const float a = ic - bc; float pm = a;
#pragma unroll
        for (int o = 1; o < 64; o <<= 1) { const float uu = __shfl_up(pm, o); if (lane >= o) pm = fmaxf(pm, uu); }
        GP[row * 4 + h] = (f32x4){bc, a, pm, pm}; }
}

__device__ __forceinline__ void mlstm_gates_reg(LAS float* GT, f32x4 gp, float m_run, int lane) {
    LAS float* ROWT = GT; LAS float* COLT = GT + 64; LAS float* WINTER = GT + 128; LAS float* WIN = GT + 192; LAS float* DFLOOR = GT + 256; LAS float* MISC = GT + 320;
    const float bc = gp[0], a = gp[1], pm = fmaxf(gp[2], gp[3]);
    const float inter = bc + m_run, mt = fmaxf(inter, bc + pm);
    const float blast = __shfl(bc, 63), amax = __shfl(pm, 63);
    const float mnew = fmaxf(blast + m_run, blast + amax);
    ROWT[lane] = bc - mt; COLT[lane] = a; WINTER[lane] = __expf(inter - mt); WIN[lane] = __expf(blast + a - mnew); DFLOOR[lane] = __expf(-mt);
    if (lane == 0) { MISC[0] = __expf(blast + m_run - mnew); MISC[1] = mnew; }
}

__device__ __forceinline__ void mlstm_prompt_item(const Params& p, LAS unsigned char* lds, int b, int h, int js) {
    constexpr int TT = 4, LV = 64, NCH = 32, KSP = 64, SLD = KSP + 8;
    int tid = threadIdx.x; asm volatile("" : "+v"(tid));
    const int lane = tid & 63, wid = __builtin_amdgcn_readfirstlane(tid >> 6);
    unsigned char* ws = p.ws; asm volatile("" : "+s"(ws));
    const bf16_t* QKC = (const bf16_t*)(ws + WS_QKC); const bf16_t* VM = (const bf16_t*)(ws + WS_Z + 4 * RSZ);
    const GAS f32x4* GP = (const GAS f32x4*)(ws + WS_GP); GAS float* DEN = (GAS float*)(ws + WS_DEN); GAS bf16_t* HM = (GAS bf16_t*)(ws + WS_HM);
    const size_t rowbase = (size_t)b * SEQ;
    const int v0 = js * 64, dbase = wid * 32;
    LAS bf16_t* Qs = (LAS bf16_t*)(lds + OFF_QS); LAS bf16_t* KK = (LAS bf16_t*)(lds + OFF_KK); LAS bf16_t* VT = (LAS bf16_t*)(lds + OFF_VT);
    LAS bf16_t* Ss = (LAS bf16_t*)(lds + OFF_SS); LAS bf16_t* Cs = (LAS bf16_t*)(lds + OFF_CS); LAS float* GT = (LAS float*)(lds + OFF_GT);
    LAS float* ROWT = GT; LAS float* COLT = GT + 64; LAS float* WINTER = GT + 128; LAS float* WIN = GT + 192; LAS float* DFLOOR = GT + 256; LAS float* MISC = GT + 320;

    f32x4 C[5][2];
#pragma unroll
    for (int vi = 0; vi < 5; ++vi)
#pragma unroll
        for (int di = 0; di < 2; ++di) C[vi][di] = (f32x4){0.f, 0.f, 0.f, 0.f};
    float m_run = 0.f;
    __syncthreads();
    for (int i = tid; i < 80 * CS_LD / 2; i += NT) ((LAS unsigned*)Cs)[i] = 0u;
    for (int i = tid; i < 16 * KSP; i += NT) { const int rr = 64 + i / KSP, s = i % KSP; VT[rr * SLD + s] = (rr == 64) ? (bf16_t)0x3F80 : (bf16_t)0; }
    for (int i = tid; i < 64 * SLD / 2; i += NT) ((LAS unsigned*)Ss)[i] = 0u;

    u32x4 qr[4], kr[4], va, vc; f32x4 gpr;
    { const int dg = tid & 31, tp = tid >> 5, vg = tid & 7, sp = (tid >> 3) & 31;
#pragma unroll
      for (int i = 0; i < 4; ++i) { qr[i] = *(const GAS u32x4*)(QKC + (rowbase + 4 * tp + i) * (2 * D) + 256 * h + 8 * dg); kr[i] = *(const GAS u32x4*)(QKC + (rowbase + 4 * tp + i) * (2 * D) + D + 256 * h + 8 * dg); }
      va = *(const GAS u32x4*)(VM + (rowbase + 2 * sp) * D + 256 * h + v0 + 8 * vg); vc = *(const GAS u32x4*)(VM + (rowbase + 2 * sp + 1) * D + 256 * h + v0 + 8 * vg);
      gpr = GP[(rowbase + lane) * 4 + h]; }
    const int ns_t = (wid >= 4) ? 2 : (wid < 2 ? 1 : 0);
    const int sidx0 = (wid >= 4) ? 2 * (wid - 4) : 8 + wid;
    const int nn_t = (wid < 4) ? 3 : 2;

    for (int ch = 0; ch < NCH; ++ch) {
        int lt = tid; asm volatile("" : "+v"(lt));
        const int fr = lt & 15, fq = (lt >> 4) & 3, dg = lt & 31, tp = lt >> 5, vg = lt & 7, sp = (lt >> 3) & 31, ln = lt & 63;
        const size_t r0 = rowbase + (size_t)ch * LV;
        if (wid == 0) mlstm_gates_reg(GT, gpr, m_run, ln);
#pragma unroll
        for (int i = 0; i < 4; ++i) { *(LAS u32x4*)(Qs + (4 * tp + i) * QS_LD + 8 * dg) = qr[i]; *(LAS u32x4*)(KK + (4 * tp + i) * QS_LD + 8 * dg) = kr[i]; }
        if (lt < 256) { const unsigned aw[4] = {va.x, va.y, va.z, va.w}, cw[4] = {vc.x, vc.y, vc.z, vc.w};
#pragma unroll
            for (int e = 0; e < 4; ++e) { *(LAS unsigned*)(VT + (8 * vg + 2 * e) * SLD + 2 * sp) = (aw[e] & 0xffffu) | (cw[e] << 16);
                                          *(LAS unsigned*)(VT + (8 * vg + 2 * e + 1) * SLD + 2 * sp) = (aw[e] >> 16) | (cw[e] & 0xffff0000u); } }
        u32x4 kc[4];
#pragma unroll
        for (int i = 0; i < 4; ++i) kc[i] = kr[i];
        if (ch + 1 < NCH) { const size_t rn = r0 + LV;
            gpr = GP[(rn + ln) * 4 + h];
#pragma unroll
            for (int i = 0; i < 4; ++i) { qr[i] = *(const GAS u32x4*)(QKC + (rn + 4 * tp + i) * (2 * D) + 256 * h + 8 * dg); kr[i] = *(const GAS u32x4*)(QKC + (rn + 4 * tp + i) * (2 * D) + D + 256 * h + 8 * dg); }
            va = *(const GAS u32x4*)(VM + (rn + 2 * sp) * D + 256 * h + v0 + 8 * vg); vc = *(const GAS u32x4*)(VM + (rn + 2 * sp + 1) * D + 256 * h + v0 + 8 * vg);
 }
        LDS_BARRIER();
        for (int j = 0; j < ns_t; ++j) { const int idx = sidx0 + j, ti = idx >= 6 ? 3 : (idx >= 3 ? 2 : (idx >= 1 ? 1 : 0)), si = idx - ti * (ti + 1) / 2;
            f32x4 acc = (f32x4){0.f, 0.f, 0.f, 0.f};
            bf16x8 kfa[8], qfa[8];
#pragma unroll
            for (int kk = 0; kk < 8; ++kk) { kfa[kk] = *(const LAS bf16x8*)(KK + (16 * si + fr) * QS_LD + 32 * kk + 8 * fq); qfa[kk] = *(const LAS bf16x8*)(Qs + (16 * ti + fr) * QS_LD + 32 * kk + 8 * fq); }
            const int t = 16 * ti + fr; const float rt = ROWT[t];
            float ct[4];
#pragma unroll
            for (int r = 0; r < 4; ++r) ct[r] = COLT[16 * si + 4 * fq + r];
            __builtin_amdgcn_s_setprio(1);
#pragma unroll
            for (int kk = 0; kk < 8; ++kk) acc = __builtin_amdgcn_mfma_f32_16x16x32_bf16(kfa[kk], qfa[kk], acc, 0, 0, 0);
            __builtin_amdgcn_s_setprio(0);
            float sv[4];
#pragma unroll
            for (int r = 0; r < 4; ++r) { const int s = 16 * si + 4 * fq + r; sv[r] = (s <= t) ? __expf(rt + ct[r]) * acc[r] : 0.f; }
            u32x2 o; o.x = pk2(sv[0], sv[1]); o.y = pk2(sv[2], sv[3]);
            *(LAS u32x2*)(Ss + t * SLD + 16 * si + 4 * fq) = o; }
        f32x4 nacc[3];
        { const int ti = wid & 3, vb = wid >> 2;
#pragma unroll
          for (int j = 0; j < 3; ++j) nacc[j] = (f32x4){0.f, 0.f, 0.f, 0.f};
          bf16x8 qfa[8];
#pragma unroll
          for (int kk = 0; kk < 8; ++kk) qfa[kk] = *(const LAS bf16x8*)(Qs + (16 * ti + fr) * QS_LD + 32 * kk + 8 * fq);
#pragma unroll
          for (int j = 0; j < 3; ++j) if (j < nn_t) { bf16x8 cfa[8];
#pragma unroll
              for (int kk = 0; kk < 8; ++kk) cfa[kk] = *(const LAS bf16x8*)(Cs + (16 * (vb + 2 * j) + fr) * CS_LD + 32 * kk + 8 * fq);
              __builtin_amdgcn_s_setprio(1);
#pragma unroll
              for (int kk = 0; kk < 8; ++kk) nacc[j] = __builtin_amdgcn_mfma_f32_16x16x32_bf16(cfa[kk], qfa[kk], nacc[j], 0, 0, 0);
              __builtin_amdgcn_s_setprio(0); }
          const float wi = WINTER[16 * ti + fr];
#pragma unroll
          for (int j = 0; j < 3; ++j) nacc[j] = nacc[j] * wi; }
        LDS_BARRIER();
        { const float w0 = WIN[4 * tp], w1 = WIN[4 * tp + 1], w2 = WIN[4 * tp + 2], w3 = WIN[4 * tp + 3];
          const unsigned k0w[4] = {kc[0].x, kc[0].y, kc[0].z, kc[0].w}, k1w[4] = {kc[1].x, kc[1].y, kc[1].z, kc[1].w}, k2w[4] = {kc[2].x, kc[2].y, kc[2].z, kc[2].w}, k3w[4] = {kc[3].x, kc[3].y, kc[3].z, kc[3].w};
#pragma unroll
          for (int e = 0; e < 4; ++e) {
              u32x2 lo, hi; lo.x = pk2(w0 * bflo(k0w[e]), w1 * bflo(k1w[e])); lo.y = pk2(w2 * bflo(k2w[e]), w3 * bflo(k3w[e]));
              hi.x = pk2(w0 * bfhi(k0w[e]), w1 * bfhi(k1w[e])); hi.y = pk2(w2 * bfhi(k2w[e]), w3 * bfhi(k3w[e]));
              const int pc = ((((tp >> 1) + (dg >> 1)) & 7) << 3) + ((tp & 1) << 2);
              *(LAS u32x2*)(KK + (8 * dg + 2 * e) * SLD + pc) = lo; *(LAS u32x2*)(KK + (8 * dg + 2 * e + 1) * SLD + pc) = hi; } }
        bf16x8 sfa[2], vfa[3][2];
#pragma unroll
        for (int kk = 0; kk < 2; ++kk) { sfa[kk] = *(const LAS bf16x8*)(Ss + (16 * (wid & 3) + fr) * SLD + 32 * kk + 8 * fq);
#pragma unroll
            for (int j = 0; j < 3; ++j) vfa[j][kk] = *(const LAS bf16x8*)(VT + (16 * ((wid >> 2) + 2 * (j < nn_t ? j : 0)) + fr) * SLD + 32 * kk + 8 * fq); }
#pragma unroll
        for (int j = 0; j < 3; ++j) if (j < nn_t) { const int ti = wid & 3, vi = (wid >> 2) + 2 * j;
            f32x4 acc = nacc[j];
#pragma unroll
            for (int kk = 0; kk < 2; ++kk) acc = __builtin_amdgcn_mfma_f32_16x16x32_bf16(vfa[j][kk], sfa[kk], acc, 0, 0, 0);
            const int t = 16 * ti + fr;
            if (vi < 4) { u32x2 o; o.x = pk2(acc[0], acc[1]); o.y = pk2(acc[2], acc[3]); *(GAS u32x2*)(HM + (r0 + t) * D + 256 * h + v0 + 16 * vi + 4 * fq) = o; }
            else if (js == 0 && fq == 0) DEN[(r0 + t) * 4 + h] = fmaxf(fabsf(acc[0]), DFLOOR[t]); }
        LDS_BARRIER();
        { const float decay = MISC[0];
          bf16x8 ktf[2][2], vtf[2][5];
#pragma unroll
          for (int kk = 0; kk < 2; ++kk) {
#pragma unroll
              for (int di = 0; di < 2; ++di) ktf[kk][di] = *(const LAS bf16x8*)(KK + (dbase + 16 * di + fr) * SLD + (((4 * kk + fq + 2 * wid + di) & 7) << 3));
#pragma unroll
              for (int vi = 0; vi < 5; ++vi) vtf[kk][vi] = *(const LAS bf16x8*)(VT + (16 * vi + fr) * SLD + 32 * kk + 8 * fq); }
#pragma unroll
          for (int vi = 0; vi < 5; ++vi)
#pragma unroll
              for (int di = 0; di < 2; ++di) C[vi][di] = C[vi][di] * decay;
          __builtin_amdgcn_s_setprio(1);
#pragma unroll
          for (int kk = 0; kk < 2; ++kk)
#pragma unroll
              for (int vi = 0; vi < 5; ++vi)
#pragma unroll
                  for (int di = 0; di < 2; ++di) C[vi][di] = __builtin_amdgcn_mfma_f32_16x16x32_bf16(ktf[kk][di], vtf[kk][vi], C[vi][di], 0, 0, 0);
          __builtin_amdgcn_s_setprio(0);
          if (ch + 1 < NCH) {
#pragma unroll
              for (int vi = 0; vi < 5; ++vi)
#pragma unroll
                  for (int di = 0; di < 2; ++di) { u32x2 o; o.x = pk2(C[vi][di][0], C[vi][di][1]); o.y = pk2(C[vi][di][2], C[vi][di][3]);
                      *(LAS u32x2*)(Cs + (16 * vi + fr) * CS_LD + dbase + 16 * di + 4 * fq) = o; } }
          m_run = MISC[1]; }
        LDS_BARRIER();
    }
    { const int fr = lane & 15, fq = lane >> 4;
      float* Co = p.out + O_CP; float* no = p.out + O_NP; float* mo = p.out + O_MP;
#pragma unroll
      for (int vi = 0; vi < 4; ++vi)
#pragma unroll
          for (int di = 0; di < 2; ++di) *(GAS f32x4*)(Co + ((size_t)(b * 4 + h) * 256 + v0 + 16 * vi + fr) * 256 + dbase + 16 * di + 4 * fq) = C[vi][di];
      if (js == 0) {
          if (fr == 0) {
#pragma unroll
              for (int di = 0; di < 2; ++di) *(GAS f32x4*)(no + (size_t)(b * 4 + h) * 256 + dbase + 16 * di + 4 * fq) = C[4][di]; }
          if (tid == 0) mo[b * 4 + h] = m_run; } }
}

__device__ __forceinline__ void mlstm_sample_valu(const Params& p, int b, int h) {
    int tid = threadIdx.x; asm volatile("" : "+v"(tid));
    const int lane = tid & 63, wid = __builtin_amdgcn_readfirstlane(tid >> 6);
    unsigned char* ws = p.ws; asm volatile("" : "+s"(ws));
    const GAS bf16_t* QKC = (const GAS bf16_t*)(ws + WS_QKC); const GAS bf16_t* VM = (const GAS bf16_t*)(ws + WS_Z + 4 * RSZ);
    const GAS float* G = (const GAS float*)(ws + WS_G); GAS float* DEN = (GAS float*)(ws + WS_DEN); GAS bf16_t* HM = (GAS bf16_t*)(ws + WS_HM);
    const size_t r0 = (size_t)NP + (size_t)b * TS;
    const GAS float* C0 = (const GAS float*)p.state_C + (size_t)(b * 4 + h) * 65536; GAS float* Co = (GAS float*)p.out + O_CS + (size_t)(b * 4 + h) * 65536;
    const int vbase = wid * 32;
    f32x4 cpre[8];
#pragma unroll
    for (int i = 0; i < 8; ++i) cpre[i] = __builtin_nontemporal_load((const GAS f32x4*)(C0 + (size_t)(vbase + i) * 256 + 4 * lane));
    float q[4][4], k[4][4], vreg[4], ic[4], fc[4];
#pragma unroll
    for (int t = 0; t < 4; ++t) { const u32x2 wq = *(const GAS u32x2*)(QKC + (r0 + t) * (2 * D) + 256 * h + 4 * lane), wk = *(const GAS u32x2*)(QKC + (r0 + t) * (2 * D) + D + 256 * h + 4 * lane);
        q[t][0] = bflo(wq.x); q[t][1] = bfhi(wq.x); q[t][2] = bflo(wq.y); q[t][3] = bfhi(wq.y); k[t][0] = bflo(wk.x); k[t][1] = bfhi(wk.x); k[t][2] = bflo(wk.y); k[t][3] = bfhi(wk.y);
        const bf16_t vv = VM[(r0 + t) * D + 256 * h + vbase + (lane & 31)]; vreg[t] = __uint_as_float((unsigned)vv << 16);
        ic[t] = G[(r0 + t) * 8 + h]; fc[t] = G[(r0 + t) * 8 + 4 + h]; }
    const float m0 = p.state_m[b * 4 + h];
    float bc[4], a[4], pm[4], mt[4], winter[4], win[4];
    bc[0] = fc[0]; bc[1] = bc[0] + fc[1]; bc[2] = bc[1] + fc[2]; bc[3] = bc[2] + fc[3];
#pragma unroll
    for (int t = 0; t < 4; ++t) a[t] = ic[t] - bc[t];
    pm[0] = a[0]; pm[1] = fmaxf(pm[0], a[1]); pm[2] = fmaxf(pm[1], a[2]); pm[3] = fmaxf(pm[2], a[3]);
#pragma unroll
    for (int t = 0; t < 4; ++t) { const float inter = bc[t] + m0; mt[t] = fmaxf(inter, bc[t] + pm[t]); winter[t] = __expf(inter - mt[t]); }
    const float blast = bc[3], mnew = fmaxf(blast + m0, blast + pm[3]), decay = __expf(blast + m0 - mnew);
#pragma unroll
    for (int s = 0; s < 4; ++s) win[s] = __expf(blast + a[s] - mnew);
    const int tl = lane >> 4;
    float wt = winter[0], rtl = bc[0] - mt[0], St[4];
#pragma unroll
    for (int t = 1; t < 4; ++t) if (tl == t) { wt = winter[t]; rtl = bc[t] - mt[t]; }
#pragma unroll
    for (int s = 0; s < 4; ++s) { float d0 = 0.f, d1 = 0.f, d2 = 0.f, d3 = 0.f;
#pragma unroll
        for (int e = 0; e < 4; ++e) { d0 += q[0][e] * k[s][e]; d1 += q[1][e] * k[s][e]; d2 += q[2][e] * k[s][e]; d3 += q[3][e] * k[s][e]; }
        d0 = wave_sum(d0); d1 = wave_sum(d1); d2 = wave_sum(d2); d3 = wave_sum(d3);
        const float dd = tl == 0 ? d0 : (tl == 1 ? d1 : (tl == 2 ? d2 : d3));
        St[s] = (s <= tl) ? __expf(rtl + a[s]) * dd : 0.f; }
#define RED4(p0, p1, p2, p3, out) do { const bool _hi = lane >= 32; \
        const float _s0 = (_hi ? p2 : p0) + __shfl_xor(_hi ? p0 : p2, 32), _s1 = (_hi ? p3 : p1) + __shfl_xor(_hi ? p1 : p3, 32); \
        const bool _h2 = (lane & 16) != 0; float _u = (_h2 ? _s1 : _s0) + __shfl_xor(_h2 ? _s0 : _s1, 16); \
        _u += __shfl_xor(_u, 8); _u += __shfl_xor(_u, 4); _u += __shfl_xor(_u, 2); _u += __shfl_xor(_u, 1); out = _u; } while (0)
    float R0 = 0.f, R1 = 0.f;
    for (int i0 = 0; i0 < 32; i0 += 8) {
        f32x4 c[8];
#pragma unroll
        for (int i = 0; i < 8; ++i) c[i] = cpre[i];
        if (i0 + 8 < 32) {
#pragma unroll
            for (int i = 0; i < 8; ++i) cpre[i] = __builtin_nontemporal_load((const GAS f32x4*)(C0 + (size_t)(vbase + i0 + 8 + i) * 256 + 4 * lane)); }
#pragma unroll
        for (int i = 0; i < 8; ++i) { const int row = i0 + i;
            float vs[4];
#pragma unroll
            for (int s = 0; s < 4; ++s) vs[s] = __shfl(vreg[s], row);
            float p0 = 0.f, p1 = 0.f, p2 = 0.f, p3 = 0.f; f32x4 cn;
#pragma unroll
            for (int e = 0; e < 4; ++e) { p0 += c[i][e] * q[0][e]; p1 += c[i][e] * q[1][e]; p2 += c[i][e] * q[2][e]; p3 += c[i][e] * q[3][e];
                cn[e] = decay * c[i][e] + ((win[0] * vs[0]) * k[0][e] + (win[1] * vs[1]) * k[1][e]) + ((win[2] * vs[2]) * k[2][e] + (win[3] * vs[3]) * k[3][e]); }
            __builtin_nontemporal_store(cn, (GAS f32x4*)(Co + (size_t)(vbase + row) * 256 + 4 * lane));
            float tot; RED4(p0, p1, p2, p3, tot);
            const float nv = wt * tot + ((St[0] * vs[0] + St[1] * vs[1]) + (St[2] * vs[2] + St[3] * vs[3]));
            if ((lane & 15) == (row & 15)) { if (row < 16) R0 = nv; else R1 = nv; } }
    }
    { const int j = lane & 15;
      GAS bf16_t* hp = HM + (r0 + tl) * D + 256 * h + vbase + j;
      hp[0] = (bf16_t)(pk2(R0, 0.f) & 0xffffu); hp[16] = (bf16_t)(pk2(R1, 0.f) & 0xffffu); }
    if (wid == 0) {
        const f32x4 nrow = *(const GAS f32x4*)(p.state_n + (size_t)(b * 4 + h) * 256 + 4 * lane);
        float p0 = 0.f, p1 = 0.f, p2 = 0.f, p3 = 0.f; f32x4 nn;
#pragma unroll
        for (int e = 0; e < 4; ++e) { p0 += nrow[e] * q[0][e]; p1 += nrow[e] * q[1][e]; p2 += nrow[e] * q[2][e]; p3 += nrow[e] * q[3][e];
            nn[e] = decay * nrow[e] + (win[0] * k[0][e] + win[1] * k[1][e]) + (win[2] * k[2][e] + win[3] * k[3][e]); }
        *(GAS f32x4*)(p.out + O_NS + (size_t)(b * 4 + h) * 256 + 4 * lane) = nn;
        float tot; RED4(p0, p1, p2, p3, tot);
        const float den = wt * tot + ((St[0] + St[1]) + (St[2] + St[3]));
        float mtl = mt[0];
#pragma unroll
        for (int t = 1; t < 4; ++t) if (tl == t) mtl = mt[t];
        if ((lane & 15) == 0) DEN[(r0 + tl) * 4 + h] = fmaxf(fabsf(den), __expf(-mtl));
        if (lane == 0) p.out[O_MS + b * 4 + h] = mnew;
    }
#undef RED4
}

__device__ __forceinline__ void gmlp_prompt_item(const Params& p, LAS unsigned char* lds, int item) {
    int tid = threadIdx.x; asm volatile("" : "+v"(tid));
    const int lane = tid & 63, wid = __builtin_amdgcn_readfirstlane(tid >> 6), fr = lane & 15, fq = lane >> 4;
    unsigned char* ws = p.ws; asm volatile("" : "+s"(ws));
    const bf16_t* U = (const bf16_t*)(ws + WS_Z); const bf16_t* GV = (const bf16_t*)(ws + WS_Z + RSZ); bf16_t* AOUT = (bf16_t*)(ws + WS_AOUT);
    const bf16_t* WSB = (const bf16_t*)(ws + WS_WSB);
    const size_t r0 = (size_t)item * 128;
    constexpr int VLD = 136;
    LAS bf16_t* VT = (LAS bf16_t*)lds;
    LAS float* MEAN = (LAS float*)(lds + 69632); LAS float* RSTD = MEAN + 128;
    __syncthreads();
#pragma unroll
    for (int grp = 0; grp < 4; ++grp) { const int row = wid * 16 + grp * 4 + fq; float s = 0.f, ss = 0.f;
#pragma unroll
        for (int i = 0; i < 8; ++i) { const u32x4 w = *(const GAS u32x4*)(GV + (r0 + row) * D + (i * 16 + fr) * 8);
            const unsigned ww[4] = {w.x, w.y, w.z, w.w};
#pragma unroll
            for (int e = 0; e < 4; ++e) { const f32x2 gg = gelu_pk((f32x2){bflo(ww[e]), bfhi(ww[e])}); const float a = gg.x, c = gg.y; s += a + c; ss += a * a + c * c; } }
#pragma unroll
        for (int o = 1; o < 16; o <<= 1) { s += __shfl_xor(s, o); ss += __shfl_xor(ss, o); }
        if (fr == 0) { const float mu = s * (1.0f / D); MEAN[row] = mu; RSTD[row] = rsqrtf(fmaxf(ss * (1.0f / D) - mu * mu, 0.f) + EPS); } }
    __syncthreads();
    const int nks = (16 * wid + 15) / 32 + 1;
    for (int g = 0; g < 4; ++g) {
        { const int s = 2 * lane; const int cb = 256 * g + 32 * wid;
          const float mu0 = MEAN[s], rs0 = RSTD[s], mu1 = MEAN[s + 1], rs1 = RSTD[s + 1];
#pragma unroll
          for (int i = 0; i < 4; ++i) { const u32x4 a = *(const GAS u32x4*)(GV + (r0 + s) * D + cb + 8 * i), c = *(const GAS u32x4*)(GV + (r0 + s + 1) * D + cb + 8 * i);
              const unsigned aw[4] = {a.x, a.y, a.z, a.w}, cw[4] = {c.x, c.y, c.z, c.w};
#pragma unroll
              for (int e = 0; e < 4; ++e) { const int c0 = cb + 8 * i + 2 * e; const float g0 = p.ln_g[c0], g1 = p.ln_g[c0 + 1], b0 = p.ln_b[c0], b1 = p.ln_b[c0 + 1];
                  const f32x2 ya = gelu_pk((f32x2){bflo(aw[e]), bfhi(aw[e])}), yc = gelu_pk((f32x2){bflo(cw[e]), bfhi(cw[e])});
                  const float x00 = (ya.x - mu0) * rs0 * g0 + b0, x01 = (ya.y - mu0) * rs0 * g1 + b1;
                  const float x10 = (yc.x - mu1) * rs1 * g0 + b0, x11 = (yc.y - mu1) * rs1 * g1 + b1;
                  *(LAS unsigned*)(VT + (32 * wid + 8 * i + 2 * e) * VLD + s) = pk2(x00, x10);
                  *(LAS unsigned*)(VT + (32 * wid + 8 * i + 2 * e + 1) * VLD + s) = pk2(x01, x11); } } }
        bf16x8 af[4];
#pragma unroll
        for (int ks = 0; ks < 4; ++ks) af[ks] = (ks < nks) ? *(const GAS bf16x8*)(WSB + ((size_t)(g * 128 + 16 * wid + fr)) * 128 + 32 * ks + 8 * fq) : (bf16x8){0, 0, 0, 0, 0, 0, 0, 0};
        const int t = 16 * wid + fr; const float bs = p.b_s[g * 128 + t];
        u32x2 uu16[16];
#pragma unroll
        for (int ci = 0; ci < 16; ++ci) uu16[ci] = *(const GAS u32x2*)(U + (r0 + t) * D + 256 * g + 16 * ci + 4 * fq);
        __syncthreads();
#pragma unroll
        for (int ci = 0; ci < 16; ++ci) {
            f32x4 acc = (f32x4){0.f, 0.f, 0.f, 0.f};
#pragma unroll
            for (int ks = 0; ks < 4; ++ks) if (ks < nks) { const bf16x8 vf = *(const LAS bf16x8*)(VT + (16 * ci + fr) * VLD + 32 * ks + 8 * fq);
                acc = __builtin_amdgcn_mfma_f32_16x16x32_bf16(vf, af[ks], acc, 0, 0, 0); }
            const size_t off = (r0 + t) * D + 256 * g + 16 * ci + 4 * fq;
            const u32x2 uu = uu16[ci];
            const f32x2 ga = gelu_pk((f32x2){bflo(uu.x), bfhi(uu.x)}), gb = gelu_pk((f32x2){bflo(uu.y), bfhi(uu.y)});
            u32x2 o; o.x = pk2(ga.x * (acc[0] + bs), ga.y * (acc[1] + bs)); o.y = pk2(gb.x * (acc[2] + bs), gb.y * (acc[3] + bs));
            *(GAS u32x2*)(AOUT + off) = o; }
        __syncthreads();
    }
}

__device__ __forceinline__ void gmlp_sample_item(const Params& p, LAS unsigned char* lds, int b) {
    int tid = threadIdx.x; asm volatile("" : "+v"(tid));
    const int lane = tid & 63, wid = tid >> 6;
    unsigned char* ws = p.ws;
    const bf16_t* U = (const bf16_t*)(ws + WS_Z); const bf16_t* GV = (const bf16_t*)(ws + WS_Z + RSZ); bf16_t* AOUT = (bf16_t*)(ws + WS_AOUT);
    const size_t r0 = (size_t)NP + (size_t)b * TS;
    LAS float* ST = (LAS float*)lds;
    __syncthreads();
    if (wid < 4) { float s = 0.f, ss = 0.f;
#pragma unroll
        for (int i = 0; i < 2; ++i) { const u32x4 w = *(const GAS u32x4*)(GV + (r0 + wid) * D + (i * 64 + lane) * 8); const unsigned ww[4] = {w.x, w.y, w.z, w.w};
#pragma unroll
            for (int e = 0; e < 4; ++e) { const f32x2 gg = gelu_pk((f32x2){bflo(ww[e]), bfhi(ww[e])}); const float a = gg.x, c = gg.y; s += a + c; ss += a * a + c * c; } }
        s = wave_sum(s); ss = wave_sum(ss);
        if (lane == 0) { const float mu = s * (1.0f / D); ST[wid] = mu; ST[4 + wid] = rsqrtf(fmaxf(ss * (1.0f / D) - mu * mu, 0.f) + EPS); } }
    __syncthreads();
    const int c0 = 2 * tid, g = c0 >> 8;
    float vn[4][2];
    const float lg0 = p.ln_g[c0], lg1 = p.ln_g[c0 + 1], lb0 = p.ln_b[c0], lb1 = p.ln_b[c0 + 1];
#pragma unroll
    for (int s = 0; s < 4; ++s) { const unsigned w = *(const GAS unsigned*)(GV + (r0 + s) * D + c0); const float mu = ST[s], rs = ST[4 + s];
        const f32x2 gy = gelu_pk((f32x2){bflo(w), bfhi(w)});
        vn[s][0] = (gy.x - mu) * rs * lg0 + lb0; vn[s][1] = (gy.y - mu) * rs * lg1 + lb1;
        *(GAS f32x2*)(p.out + O_GMV + ((size_t)b * TS + s) * D + c0) = (f32x2){vn[s][0], vn[s][1]}; }
#pragma unroll
    for (int t = 0; t < 4; ++t) { float s0 = p.b_s[g * 128 + t], s1 = s0;
#pragma unroll
        for (int s = 0; s < 4; ++s) if (s <= t) { const float w = p.w_s[(size_t)(g * 128 + t) * 128 + s]; s0 += w * vn[s][0]; s1 += w * vn[s][1]; }
        const unsigned uu = *(const GAS unsigned*)(U + (r0 + t) * D + c0);
        const f32x2 gu = gelu_pk((f32x2){bflo(uu), bfhi(uu)});
        *(GAS unsigned*)(AOUT + (r0 + t) * D + c0) = pk2(gu.x * s0, gu.y * s1); }
}

__device__ __forceinline__ void conv_state_item(const Params& p, int seq) {
    const bf16_t* QK = (const bf16_t*)(p.ws + WS_Z + 2 * RSZ);
    const bool sample = seq >= NB_P; const int b = sample ? seq - NB_P : seq;
    const size_t rsrc = sample ? (size_t)NP + (size_t)b * TS + 1 : (size_t)b * SEQ + (SEQ - 3);
    float* dst = p.out + (sample ? O_CONVS : O_CONVP) + (size_t)b * 3 * 2 * D;
    int tid = threadIdx.x; asm volatile("" : "+v"(tid));
    for (int i = tid; i < 3 * 2 * D / 2; i += NT) { const unsigned w = ((const unsigned*)(QK + rsrc * 2 * D))[i]; *(GAS f32x2*)(dst + 2 * i) = (f32x2){bflo(w), bfhi(w)}; }
}

constexpr int LW_P = 16 * 32, LW_F1 = 16 * 176, LW_F2 = 44 * 32, LW_ALL = 3 * LW_P + LW_F1 + LW_F2, LW_ITEMS = LW_ALL / 8;
__device__ __forceinline__ void late_weight_item(const Params& p, LAS unsigned char* lds, int item) {
    int tid = threadIdx.x; asm volatile("" : "+v"(tid));
    const int lane = tid & 63, wid = tid >> 6;
    unsigned char* ws = p.ws; asm volatile("" : "+s"(ws));
    LAS float* scr = (LAS float*)(lds + wid * 8448);
    __syncthreads();
    int r = item * 8 + wid;
    if (r < LW_P) { transpose_item(p.w_proj_a, D, D, (bf16_t*)(ws + WS_WPA), (r / 32) * 64, (r % 32) * 32, (r % 32) * 32, scr, lane); return; } r -= LW_P;
    if (r < LW_P) { transpose_item(p.w_proj_b, D, D, (bf16_t*)(ws + WS_WPB), (r / 32) * 64, (r % 32) * 32, (r % 32) * 32, scr, lane); return; } r -= LW_P;
    if (r < LW_P) { transpose_item(p.w_out, D, D, (bf16_t*)(ws + WS_WO), (r / 32) * 64, (r % 32) * 32, (r % 32) * 32, scr, lane); return; } r -= LW_P;
    if (r < LW_F1) { const int kb = r / 176, nb = r % 176, n0 = nb * 32, pn = n0 >> 8, within = n0 & 255, half = within >> 7, jj0 = within & 127;
        transpose_item(p.w_ffn_in, 2 * DFF, D, (bf16_t*)(ws + WS_WF1), kb * 64, half * DFF + 128 * pn + jj0, n0, scr, lane); return; } r -= LW_F1;
    transpose_item(p.w_ffn_out, D, DFF, (bf16_t*)(ws + WS_WF2), (r / 32) * 64, (r % 32) * 32, (r % 32) * 32, scr, lane);
}

__device__ __forceinline__ void phase_bout(const Params& p) {
    int tid = threadIdx.x; asm volatile("" : "+v"(tid));
    const int lane = tid & 63, wid = tid >> 6, gw = blockIdx.x * NWAVES + wid, NGW = gridDim.x * NWAVES;
    const GAS bf16_t* HM = (const GAS bf16_t*)(p.ws + WS_HM); const GAS bf16_t* SO = (const GAS bf16_t*)(p.ws + WS_Z + 5 * RSZ); const GAS float* DEN = (const GAS float*)(p.ws + WS_DEN);
    GAS bf16_t* BOUT = (GAS bf16_t*)(p.ws + WS_BOUT);
    f32x4 g4[4];
#pragma unroll
    for (int hh = 0; hh < 4; ++hh) g4[hh] = *(const GAS f32x4*)(p.hn_g + 256 * hh + 4 * lane);
    for (int row0 = gw; row0 < MT; row0 += 2 * NGW) {
        u32x2 w[2][4], so[2][4]; f32x4 dn[2];
#pragma unroll
        for (int rr = 0; rr < 2; ++rr) { const int row = (row0 + rr * NGW < MT) ? row0 + rr * NGW : row0;
            dn[rr] = *(const GAS f32x4*)(DEN + (size_t)row * 4);
#pragma unroll
            for (int hh = 0; hh < 4; ++hh) { const size_t off = (size_t)row * D + 256 * hh + 4 * lane; w[rr][hh] = *(const GAS u32x2*)(HM + off); so[rr][hh] = *(const GAS u32x2*)(SO + off); } }
#pragma unroll
        for (int rr = 0; rr < 2; ++rr) { const int row = row0 + rr * NGW; if (row < MT) {
#pragma unroll
            for (int hh = 0; hh < 4; ++hh) {
                const size_t off = (size_t)row * D + 256 * hh + 4 * lane; const float inv = 1.0f / dn[rr][hh];
                float x[4] = {bflo(w[rr][hh].x) * inv, bfhi(w[rr][hh].x) * inv, bflo(w[rr][hh].y) * inv, bfhi(w[rr][hh].y) * inv};
                const float mu = wave_sum((x[0] + x[1]) + (x[2] + x[3])) * (1.0f / 256.f);
                float q = 0.f;
#pragma unroll
                for (int e = 0; e < 4; ++e) { x[e] -= mu; q += x[e] * x[e]; }
                const float rs = rsqrtf(wave_sum(q) * (1.0f / 256.f) + EPS);
                u32x2 o; o.x = pk2(sigmoid_f(bflo(so[rr][hh].x)) * x[0] * rs * g4[hh][0], sigmoid_f(bfhi(so[rr][hh].x)) * x[1] * rs * g4[hh][1]); o.y = pk2(sigmoid_f(bflo(so[rr][hh].y)) * x[2] * rs * g4[hh][2], sigmoid_f(bfhi(so[rr][hh].y)) * x[3] * rs * g4[hh][3]);
                *(GAS u32x2*)(BOUT + off) = o; } } }
    }
}
template <bool TO_BF16>
__device__ __forceinline__ void phase_rms(const Params& p, const float* gain, bf16_t* dst, int rbeg = 0) {
    int tid = threadIdx.x; asm volatile("" : "+v"(tid));
    const int lane = tid & 63, wid = tid >> 6, gw = blockIdx.x * NWAVES + wid, NGW = gridDim.x * NWAVES;
    const GAS bf16_t* XB = (const GAS bf16_t*)(p.ws + WS_BOUT); GAS float* Y = (GAS float*)p.out + O_Y;
    f32x4 g4[4];
#pragma unroll
    for (int j = 0; j < 4; ++j) g4[j] = ((const GAS f32x4*)gain)[lane + 64 * j];
    for (int row0 = rbeg + gw; row0 < MT; row0 += 4 * NGW) {
        u32x2 v[4][4];
#pragma unroll
        for (int rr = 0; rr < 4; ++rr) { const int row = (row0 + rr * NGW < MT) ? row0 + rr * NGW : row0;
#pragma unroll
            for (int j = 0; j < 4; ++j) v[rr][j] = ((const GAS u32x2*)(XB + (size_t)row * D))[lane + 64 * j]; }
#pragma unroll
        for (int rr = 0; rr < 4; ++rr) { const int row = row0 + rr * NGW; if (row < MT) {
            f32x4 x[4]; float ss = 0.f;
#pragma unroll
            for (int j = 0; j < 4; ++j) { x[j] = (f32x4){bflo(v[rr][j].x), bfhi(v[rr][j].x), bflo(v[rr][j].y), bfhi(v[rr][j].y)}; ss += (x[j][0] * x[j][0] + x[j][1] * x[j][1]) + (x[j][2] * x[j][2] + x[j][3] * x[j][3]); }
            const float r = rsqrtf(wave_sum(ss) * (1.0f / D) + EPS);
#pragma unroll
            for (int j = 0; j < 4; ++j) { const f32x4 o4 = x[j] * r * g4[j];
                if (TO_BF16) { u32x2 o; o.x = pk2(o4[0], o4[1]); o.y = pk2(o4[2], o4[3]); ((GAS u32x2*)((GAS bf16_t*)dst + (size_t)row * D))[lane + 64 * j] = o; }
                else ((GAS f32x4*)(Y + (size_t)row * D))[lane + 64 * j] = o4; } } }
    }
}

#ifndef PHMASK
#define PHMASK 0xFFFF
#endif
__global__ void __launch_bounds__(NT) fwd_megakernel(Params p) {
    extern __shared__ __attribute__((aligned(16))) unsigned char lds_raw[];
    LAS unsigned char* lds = (LAS unsigned char*)lds_raw;
    unsigned char* ws = p.ws;
    const int G = gridDim.x, bid = blockIdx.x;
    const int tid = threadIdx.x, lane = tid & 63, wid = __builtin_amdgcn_readfirstlane(tid >> 6), fr = lane & 15, fq = lane >> 4;
    volatile LAS unsigned* xst = (volatile LAS unsigned*)(lds + LDS_BYTES - 32);
    if (tid == 0) { xst[0] = 0u; xst[1] = 0u; }
    __syncthreads();
    const XcdBarrier bar = xcd_barrier_post((unsigned*)(ws + WS_CTL), xst);
#define GRID_BAR() xcd_barrier(bar)

#if PHMASK & 1
    phase0(p, lds);
#endif
    GRID_BAR();
#if PHMASK & 2
    { pg8::Gemm g{(const bf16_t*)(ws + WS_H), (const bf16_t*)(ws + WS_WZ), MT, NZ, D}; pg8::StaticOrder S; S.init(MT, NZ, G, bid);
      EpiZ E{(bf16_t*)(ws + WS_Z), p.b_gate}; pg8::gemm_phase(lds, g, S, E); }
    { constexpr int NU = (MT / 256) * (NZ / 256); const int extra = NU % G;
      if (bid >= extra) for (int it = bid - extra; it < LW_ITEMS; it += G - extra) late_weight_item(p, lds, it); }
#endif
    GRID_BAR();
#if PHMASK & 1024
    phase_conv(p);
    phase_gate_scan(p);
    for (int it = bid; it < NB_P + NB_S; it += G) conv_state_item(p, it);
#endif
    GRID_BAR();
#if PHMASK & 4
#ifndef REP2
#define REP2 1
#endif
    for (int rep = 0; rep < REP2; ++rep) {
      for (int it = bid; it < 128; it += G) { const int xcd = it & 7, k = it >> 3, bh = xcd * 4 + (k >> 2);
          mlstm_prompt_item(p, lds, bh >> 2, bh & 3, k & 3); }
      unsigned* qctr = (unsigned*)(ws + WS_CTL) + 16 * rep;
      LAS int* qslot = (LAS int*)(lds + LDS_BYTES - 16);
      constexpr int N_A = 128, N_B = 512, N_C = 128, N_ALL = N_A + N_B + N_C;
      int nxt = 0;
      if (threadIdx.x == 0) nxt = (int)atomicAdd(qctr, 1u);
      for (;;) {
          __syncthreads();
          if (threadIdx.x == 0) *qslot = nxt;
          __syncthreads();
          int it = *qslot;
          if (it >= N_ALL) break;
          if (threadIdx.x == 0) nxt = (int)atomicAdd(qctr, 1u);
          if (it < N_A) { gmlp_prompt_item(p, lds, it); continue; }
          it -= N_A;
          if (it < N_B) { mlstm_sample_valu(p, it >> 2, it & 3); continue; }
          it -= N_B;
          gmlp_sample_item(p, lds, it);
      } }
#endif
    GRID_BAR();
#if PHMASK & 8
    { pg8::StaticOrder S; S.init(NP, D, G, bid);
      pg8::Gemm g{(const bf16_t*)(ws + WS_AOUT), (const bf16_t*)(ws + WS_WPA), NP, D, D}; EpiT1 E{(bf16_t*)(ws + WS_Z), (const bf16_t*)(ws + WS_Z + 6 * RSZ)};
      if (bid & 1) { pg8::gemm_phase(lds, g, S, E); phase_bout(p); }
      else { phase_bout(p); pg8::gemm_phase(lds, g, S, E); } }
#endif
    GRID_BAR();
#if PHMASK & 16
    { pg8::StaticOrder S; S.init(NP, D, G, bid);
      { pg8::Gemm g{(const bf16_t*)(ws + WS_BOUT), (const bf16_t*)(ws + WS_WPB), NP, D, D}; EpiT2 E{(const bf16_t*)(ws + WS_Z), (const bf16_t*)(ws + WS_Z + 7 * RSZ), (bf16_t*)(ws + WS_H)}; pg8::gemm_phase(lds, g, S, E); }
      for (int tl = bid; tl < 256; tl += G) { const int r0 = NP + (tl >> 5) * 64, c0 = (tl & 31) * 32;
          f32x4 acc[4][2]; ZERO_ACC42(acc);
          small_tile_mma<D>((const bf16_t*)(ws + WS_AOUT), (const bf16_t*)(ws + WS_WPA), r0, c0, wid, fr, fq, acc);
          const f32x4 pa = small_tile_reduce(lds, acc, wid, fr, fq);
          ZERO_ACC42(acc);
          small_tile_mma<D>((const bf16_t*)(ws + WS_BOUT), (const bf16_t*)(ws + WS_WPB), r0, c0, wid, fr, fq, acc);
          const f32x4 pb = small_tile_reduce(lds, acc, wid, fr, fq);
          const size_t off = (size_t)(r0 + (tid >> 3)) * D + c0 + 4 * (tid & 7);
          const u32x2 ga = *(const GAS u32x2*)((const bf16_t*)(ws + WS_Z + 6 * RSZ) + off), gb = *(const GAS u32x2*)((const bf16_t*)(ws + WS_Z + 7 * RSZ) + off);
          u32x2 o; o.x = pk2(bflo(ga.x) * pa[0] + bflo(gb.x) * pb[0], bfhi(ga.x) * pa[1] + bfhi(gb.x) * pb[1]);
          o.y = pk2(bflo(ga.y) * pa[2] + bflo(gb.y) * pb[2], bfhi(ga.y) * pa[3] + bfhi(gb.y) * pb[3]);
          *(GAS u32x2*)((bf16_t*)(ws + WS_H) + off) = o; } }
#endif
    GRID_BAR();
#if PHMASK & 32
    { pg8::Gemm g{(const bf16_t*)(ws + WS_H), (const bf16_t*)(ws + WS_WO), NP, D, D}; pg8::StaticOrder S; S.init(NP, D, G, bid);
      if (G == (NP / 256) * (D / 256)) { EpiNorm<true> E{p.x_prompt, (bf16_t*)(ws + WS_BOUT), (bf16_t*)(ws + WS_AOUT), nullptr, p.g_norm2, (float*)(ws + WS_XS), (unsigned*)(ws + WS_PCNT), (unsigned*)(ws + WS_CTL) + 60, 32u}; pg8::gemm_phase(lds, g, S, E); }
      else { EpiRes<true> E{p.x_prompt, (bf16_t*)(ws + WS_BOUT)}; pg8::gemm_phase(lds, g, S, E); }
      for (int tl = bid; tl < 256; tl += G) { const int r0 = NP + (tl >> 5) * 64, c0 = (tl & 31) * 32;
          f32x4 acc[4][2]; ZERO_ACC42(acc);
          small_tile_mma<D>((const bf16_t*)(ws + WS_H), (const bf16_t*)(ws + WS_WO), r0, c0, wid, fr, fq, acc);
          const f32x4 pa = small_tile_reduce(lds, acc, wid, fr, fq);
          const int row = r0 + (tid >> 3), col = c0 + 4 * (tid & 7);
          const f32x4 o = *(const GAS f32x4*)(p.x_sample + (size_t)(row - NP) * D + col) + pa;
          u32x2 w; w.x = pk2(o[0], o[1]); w.y = pk2(o[2], o[3]); *(GAS u32x2*)((bf16_t*)(ws + WS_BOUT) + (size_t)row * D + col) = w; } }
#endif
    GRID_BAR();
#if PHMASK & 64
    phase_rms<true>(p, p.g_norm2, (bf16_t*)(ws + WS_AOUT), G == (NP / 256) * (D / 256) ? NP : 0);
#endif
    GRID_BAR();
#if PHMASK & 128
    { pg8::Gemm g{(const bf16_t*)(ws + WS_AOUT), (const bf16_t*)(ws + WS_WF1), MT, 2 * DFF, D}; pg8::StaticOrder S; S.init(MT, 2 * DFF, G, bid);
      EpiFfn E{(bf16_t*)(ws + WS_Z)}; pg8::gemm_phase(lds, g, S, E); }
#endif
    GRID_BAR();
#if PHMASK & 256
    { pg8::Gemm g{(const bf16_t*)(ws + WS_Z), (const bf16_t*)(ws + WS_WF2), NP, D, DFF}; pg8::StaticOrder S; S.init(NP, D, G, bid);
      if (G == (NP / 256) * (D / 256)) { EpiNorm<false> E{nullptr, (bf16_t*)(ws + WS_BOUT), nullptr, p.out + O_Y, p.g_final, (float*)(ws + WS_XS), (unsigned*)(ws + WS_PCNT), (unsigned*)(ws + WS_CTL) + 60, 64u}; pg8::gemm_phase(lds, g, S, E); }
      else { EpiRes<false> E{nullptr, (bf16_t*)(ws + WS_BOUT)}; pg8::gemm_phase(lds, g, S, E); }
      for (int tl = bid; tl < 256; tl += G) { const int r0 = NP + (tl >> 5) * 64, c0 = (tl & 31) * 32;
          f32x4 acc[4][2]; ZERO_ACC42(acc);
          small_tile_mma<DFF>((const bf16_t*)(ws + WS_Z), (const bf16_t*)(ws + WS_WF2), r0, c0, wid, fr, fq, acc);
          const f32x4 pa = small_tile_reduce(lds, acc, wid, fr, fq);
          GAS u32x2* xp2 = (GAS u32x2*)((bf16_t*)(ws + WS_BOUT) + (size_t)(r0 + (tid >> 3)) * D + c0 + 4 * (tid & 7));
          const u32x2 t = *xp2; u32x2 w; w.x = pk2(bflo(t.x) + pa[0], bfhi(t.x) + pa[1]); w.y = pk2(bflo(t.y) + pa[2], bfhi(t.y) + pa[3]); *xp2 = w; } }
#endif
    GRID_BAR();
#if PHMASK & 512
    phase_rms<false>(p, p.g_final, nullptr, G == (NP / 256) * (D / 256) ? NP : 0);
#endif
}

extern "C" void kernel_launch(void* const* d_in, const int* in_sizes, int n_in, void* d_out, int out_size, void* d_ws, size_t ws_size, hipStream_t stream) {
    static int grid_blocks = 0;
    if (grid_blocks == 0) {
        if (n_in != 25 || ws_size < WS_END) { fprintf(stderr, "kernel_launch: unexpected inputs (%d) or workspace (%zu < %zu)\n", n_in, ws_size, (size_t)WS_END); grid_blocks = -1; return; }
        int dev = 0, cus = 0, per_cu = 0;
        hipGetDevice(&dev);
        hipDeviceGetAttribute(&cus, hipDeviceAttributeMultiprocessorCount, dev);
        if (hipFuncSetAttribute((const void*)fwd_megakernel, hipFuncAttributeMaxDynamicSharedMemorySize, LDS_BYTES) != hipSuccess) { fprintf(stderr, "kernel_launch: hipFuncSetAttribute failed\n"); grid_blocks = -1; return; }
        if (hipOccupancyMaxActiveBlocksPerMultiprocessor(&per_cu, (const void*)fwd_megakernel, NT, LDS_BYTES) != hipSuccess || per_cu < 1) { fprintf(stderr, "kernel_launch: occupancy query failed (%d)\n", per_cu); (void)hipGetLastError(); per_cu = 1; }
        grid_blocks = cus * per_cu;
        if (grid_blocks > 256) grid_blocks = 256;
    }
    if (grid_blocks < 0) return;
    (void)hipMemsetAsync((char*)d_ws + WS_CTL, 0, 32768, stream);
    Params p{};
    const float* const* in = (const float* const*)d_in;
    p.x_prompt = in[0]; p.x_sample = in[1]; p.state_conv = in[2]; p.state_C = in[3]; p.state_n = in[4]; p.state_m = in[5];
    p.g_norm1 = in[6]; p.w_in = in[7]; p.b_i = in[8]; p.b_f = in[9]; p.ln_g = in[10]; p.ln_b = in[11]; p.w_s = in[12]; p.b_s = in[13];
    p.conv_w = in[14]; p.conv_b = in[15]; p.hn_g = in[16]; p.b_gate = in[17]; p.w_proj_a = in[18]; p.w_proj_b = in[19]; p.w_out = in[20];
    p.g_norm2 = in[21]; p.w_ffn_in = in[22]; p.w_ffn_out = in[23]; p.g_final = in[24];
    p.out = (float*)d_out; p.ws = (unsigned char*)d_ws;
    void* args[] = {&p};
    hipError_t e = hipLaunchCooperativeKernel((const void*)fwd_megakernel, dim3(grid_blocks), dim3(NT), args, LDS_BYTES, stream);
    if (e != hipSuccess) fprintf(stderr, "cooperative launch failed: %s (grid %d)\n", hipGetErrorString(e), grid_blocks);
}
```
